# Optimizing an MI355X kernel written in HIP

```python
import math
import jax
import jax.numpy as jnp
from jax import lax
import numpy as np

D_MODEL = 1024
BATCH = 8
SEQ = 4096
DEPTH = 2

QB = 128
NEG_INF = -1e30
BIG = 1e9
NORM_EPS = 1e-6

DIFF_HEADS = 4
DIFF_DH = 64
MLA_HEADS = 4
MLA_NOPE = 128
MLA_ROPE = 64
MLA_VDIM = 128
MLA_Q_LORA = 256
MLA_KV_LORA = 256
ROPE_THETA = 10000.0
FOX_HEADS = 4
FOX_DH = 128
NSA_HEADS = 8
NSA_GROUPS = 2
NSA_HPG = NSA_HEADS // NSA_GROUPS
NSA_DH = 64
CMP_STRIDE = 16
CMP_LEN = 2 * CMP_STRIDE
CMP_HIDDEN = 128
SLC_LEN = 64
SLC_TOPK = 8
WINDOW = 256
N_BRANCH = 4
BRANCH_WIDTH = 512
D_FF = 2816
CONV_WIDTH = 3

IN_WIDTHS = (
    DIFF_HEADS * 2 * DIFF_DH,
    DIFF_HEADS * 2 * DIFF_DH,
    DIFF_HEADS * 2 * DIFF_DH,
    MLA_Q_LORA,
    MLA_KV_LORA,
    MLA_ROPE,
    FOX_HEADS * FOX_DH,
    FOX_HEADS * FOX_DH,
    FOX_HEADS * FOX_DH,
    FOX_HEADS,
    NSA_HEADS * NSA_DH,
    3 * 2 * NSA_GROUPS * NSA_DH,
    3 * NSA_HEADS,
    N_BRANCH * D_MODEL,
)
N_IN = sum(IN_WIDTHS)

kernel_name = 'hybrid_gated_four_mixer_trunk'


def rms_norm(t, g):
    tf = t.astype(jnp.float32)
    y = tf * lax.rsqrt(jnp.mean(tf * tf, axis=-1, keepdims=True) + NORM_EPS)
    return (y * g.astype(jnp.float32)).astype(t.dtype)


def masked_softmax(s, mask):
    p = jax.nn.softmax(jnp.where(mask, s, NEG_INF), axis=-1)
    return jnp.where(mask, p, 0.0)


def alibi_slopes(n):
    return jnp.asarray(np.exp2(-8.0 * np.arange(1, n + 1) / n), dtype=jnp.float32)


def rope(t, pos):
    d = t.shape[-1]
    inv_freq = ROPE_THETA ** (-jnp.arange(0, d, 2, dtype=jnp.float32) / d)
    ang = pos.astype(jnp.float32)[:, None] * inv_freq[None, :]
    cos, sin = jnp.cos(ang), jnp.sin(ang)
    tf = t.astype(jnp.float32)
    t1, t2 = tf[..., : d // 2], tf[..., d // 2:]
    return jnp.concatenate([t1 * cos - t2 * sin, t2 * cos + t1 * sin], axis=-1).astype(t.dtype)


def to_blocks(a, seq_axis):
    seq_axis = seq_axis % a.ndim
    s = a.shape[seq_axis]
    a = a.reshape(a.shape[:seq_axis] + (s // QB, QB) + a.shape[seq_axis + 1:])
    return jnp.moveaxis(a, seq_axis, 0)


def from_blocks(o):
    o = jnp.moveaxis(o, 0, -3)
    return o.reshape(o.shape[:-3] + (o.shape[-3] * o.shape[-2], o.shape[-1]))


def merge_heads(t):
    t = jnp.moveaxis(t, -2, 1)
    return t.reshape(t.shape[0], t.shape[1], -1)


def diff_attention(q, k, v, lam, lam_init, subln_g):
    s, d = q.shape[-2], q.shape[-1]
    slopes = alibi_slopes(q.shape[1])[None, :, None, None, None]
    k_pos = jnp.arange(s)

    def block(args):
        i, qb = args
        q_pos = i * QB + jnp.arange(QB)
        dist = q_pos[:, None] - k_pos[None, :]
        sc = jnp.einsum('bhcqd,bhcsd->bhcqs', qb, k, preferred_element_type=jnp.float32) * d ** -0.5
        sc = sc - slopes * dist.astype(jnp.float32)
        p = masked_softmax(sc, dist >= 0)
        a = p[:, :, 0] - lam * p[:, :, 1]
        return jnp.einsum('bhqs,bhsd->bhqd', a.astype(v.dtype), v)

    o = from_blocks(lax.map(block, (jnp.arange(s // QB), to_blocks(q, -2))))
    return rms_norm(o, subln_g) * (1.0 - lam_init)


def mla_attention(c_q, c_kv, k_rope_in, norm_q, w_uq, norm_kv, w_ukv):
    b, s, _ = c_q.shape
    pos = jnp.arange(s)
    q = (rms_norm(c_q, norm_q) @ w_uq).reshape(b, s, MLA_HEADS, MLA_NOPE + MLA_ROPE).transpose(0, 2, 1, 3)
    q_nope, q_pe = q[..., :MLA_NOPE], rope(q[..., MLA_NOPE:], pos)
    kv = (rms_norm(c_kv, norm_kv) @ w_ukv).reshape(b, s, MLA_HEADS, MLA_NOPE + MLA_VDIM).transpose(0, 2, 1, 3)
    k_nope, v = kv[..., :MLA_NOPE], kv[..., MLA_NOPE:]
    k_pe = rope(k_rope_in, pos)
    scale = (MLA_NOPE + MLA_ROPE) ** -0.5

    def block(args):
        i, qn, qr = args
        q_pos = i * QB + jnp.arange(QB)
        mask = pos[None, :] <= q_pos[:, None]
        sc = (jnp.einsum('bhqd,bhsd->bhqs', qn, k_nope, preferred_element_type=jnp.float32)
              + jnp.einsum('bhqd,bsd->bhqs', qr, k_pe, preferred_element_type=jnp.float32)) * scale
        p = masked_softmax(sc, mask)
        return jnp.einsum('bhqs,bhsd->bhqd', p.astype(v.dtype), v)

    return from_blocks(lax.map(block, (jnp.arange(s // QB), to_blocks(q_nope, -2), to_blocks(q_pe, -2))))


def forgetting_attention(q, k, v, log_f):
    s, d = q.shape[-2], q.shape[-1]
    c = lax.cumsum(log_f, axis=2)
    k_pos = jnp.arange(s)

    def block(args):
        i, qb, cq = args
        q_pos = i * QB + jnp.arange(QB)
        mask = k_pos[None, :] <= q_pos[:, None]
        sc = jnp.einsum('bhqd,bhsd->bhqs', qb, k, preferred_element_type=jnp.float32) * d ** -0.5
        sc = sc + (cq[..., :, None] - c[..., None, :])
        p = masked_softmax(sc, mask)
        return jnp.einsum('bhqs,bhsd->bhqd', p.astype(v.dtype), v)

    return from_blocks(lax.map(block, (jnp.arange(s // QB), to_blocks(q, -2), to_blocks(c, -1))))


def compress(kx, pe, w1, w2):
    b, g, s, d = kx.shape
    ch = kx.reshape(b, g, s // CMP_STRIDE, CMP_STRIDE, d)
    blocks = jnp.concatenate([ch[:, :, :-1], ch[:, :, 1:]], axis=3) + pe
    return jax.nn.gelu(blocks.reshape(b, g, -1, CMP_LEN * d) @ w1) @ w2


def nsa_attention(q, gates, kv, cmp_pe, cmp_w1, cmp_w2):
    b, g, hg, s, d = q.shape
    scale = d ** -0.5
    slopes = alibi_slopes(NSA_HEADS).reshape(g, hg)[None, :, :, None, None]
    k_c = compress(kv[0, 0], cmp_pe[0], cmp_w1[0], cmp_w2[0])
    v_c = compress(kv[0, 1], cmp_pe[1], cmp_w1[1], cmp_w2[1])
    n_c = k_c.shape[2]
    cmp_start = jnp.arange(n_c) * CMP_STRIDE
    cmp_end = cmp_start + CMP_LEN - 1
    n_sel = s // SLC_LEN
    n_topk = min(SLC_TOPK, n_sel)
    sel_start = jnp.arange(n_sel) * SLC_LEN
    overlap = jnp.maximum(
        jnp.minimum(cmp_start[:, None] + CMP_LEN, sel_start[None, :] + SLC_LEN)
        - jnp.maximum(cmp_start[:, None], sel_start[None, :]), 0).astype(jnp.float32) / CMP_LEN
    k_s = kv[1, 0].reshape(b, g, n_sel, SLC_LEN, d)
    v_s = kv[1, 1].reshape(b, g, n_sel, SLC_LEN, d)
    pad = ((0, 0), (0, 0), (WINDOW, 0), (0, 0))
    k_w = jnp.pad(kv[2, 0], pad)
    v_w = jnp.pad(kv[2, 1], pad)
    gather = jax.vmap(jax.vmap(lambda blk, ix: blk[ix]))

    def block(args):
        i, qb, gb = args
        q_pos = i * QB + jnp.arange(QB)
        dist_c = q_pos[:, None] - cmp_end[None, :]
        sc = jnp.einsum('bghqd,bgcd->bghqc', qb, k_c, preferred_element_type=jnp.float32) * scale
        p_c = masked_softmax(sc - slopes * dist_c.astype(jnp.float32), dist_c >= 0)
        o_c = jnp.einsum('bghqc,bgcd->bghqd', p_c.astype(v_c.dtype), v_c)
        imp = jnp.einsum('bghqc,cj->bgqj', p_c, overlap)
        blk = (q_pos // SLC_LEN)[:, None]
        j = jnp.arange(n_sel)[None, :]
        forced = (j == 0) | (j == blk) | (j == blk - 1)
        imp = jnp.where(j > blk, NEG_INF, jnp.where(forced, BIG, imp))
        _, idx = lax.top_k(imp, n_topk)
        k_g = gather(k_s, idx)
        v_g = gather(v_s, idx)
        key_pos = idx[..., None] * SLC_LEN + jnp.arange(SLC_LEN)
        dist_s = (q_pos[:, None, None] - key_pos)[:, :, None]
        sc = jnp.einsum('bghqd,bgqkld->bghqkl', qb, k_g, preferred_element_type=jnp.float32) * scale
        sc = sc - slopes[..., None] * dist_s.astype(jnp.float32)
        p_s = masked_softmax(sc.reshape(b, g, hg, QB, n_topk * SLC_LEN),
                             (dist_s >= 0).reshape(b, g, 1, QB, n_topk * SLC_LEN))
        o_s = jnp.einsum('bghqn,bgqnd->bghqd', p_s.astype(v_g.dtype),
                         v_g.reshape(b, g, QB, n_topk * SLC_LEN, d))
        k_wb = lax.dynamic_slice_in_dim(k_w, i * QB, WINDOW + QB, axis=2)
        v_wb = lax.dynamic_slice_in_dim(v_w, i * QB, WINDOW + QB, axis=2)
        key_pos_w = i * QB - WINDOW + jnp.arange(WINDOW + QB)
        dist_w = q_pos[:, None] - key_pos_w[None, :]
        mask_w = (dist_w >= 0) & (dist_w < WINDOW) & (key_pos_w[None, :] >= 0)
        sc = jnp.einsum('bghqd,bgkd->bghqk', qb, k_wb, preferred_element_type=jnp.float32) * scale
        p_w = masked_softmax(sc - slopes * dist_w.astype(jnp.float32), mask_w)
        o_w = jnp.einsum('bghqk,bgkd->bghqd', p_w.astype(v_wb.dtype), v_wb)
        return gb[..., 0:1] * o_c + gb[..., 1:2] * o_s + gb[..., 2:3] * o_w

    return from_blocks(lax.map(block, (jnp.arange(s // QB), to_blocks(q, -2), to_blocks(gates, -2))))


def token_mixers(h, layer_idx, w_in, diff_lambda, diff_subln, mla_norm_q, mla_w_uq, mla_norm_kv,
                 mla_w_ukv, fox_b_f, nsa_cmp_pe, nsa_cmp_w1, nsa_cmp_w2, w_branch, w_out):
    b, s, _ = h.shape
    proj = h @ w_in
    (a_q, a_k, a_v, b_cq, b_ckv, b_kr, c_q, c_k, c_v, c_f,
     d_q, d_kv, d_g, gate) = jnp.split(proj, np.cumsum(IN_WIDTHS)[:-1].tolist(), axis=-1)

    lam_init = 0.8 - 0.6 * math.exp(-0.3 * layer_idx)
    lf = diff_lambda.astype(jnp.float32)
    lam = jnp.exp(jnp.sum(lf[0] * lf[1])) - jnp.exp(jnp.sum(lf[2] * lf[3])) + lam_init
    qa = a_q.reshape(b, s, DIFF_HEADS, 2, DIFF_DH).transpose(0, 2, 3, 1, 4)
    ka = a_k.reshape(b, s, DIFF_HEADS, 2, DIFF_DH).transpose(0, 2, 3, 1, 4)
    va = a_v.reshape(b, s, DIFF_HEADS, 2 * DIFF_DH).transpose(0, 2, 1, 3)
    y_a = merge_heads(diff_attention(qa, ka, va, lam, lam_init, diff_subln))

    y_b = merge_heads(mla_attention(b_cq, b_ckv, b_kr, mla_norm_q, mla_w_uq, mla_norm_kv, mla_w_ukv))

    def heads(t):
        return t.reshape(b, s, FOX_HEADS, FOX_DH).transpose(0, 2, 1, 3)
    log_f = jax.nn.log_sigmoid((c_f + fox_b_f).astype(jnp.float32)).transpose(0, 2, 1)
    y_c = merge_heads(forgetting_attention(heads(c_q), heads(c_k), heads(c_v), log_f))

    qd = d_q.reshape(b, s, NSA_GROUPS, NSA_HPG, NSA_DH).transpose(0, 2, 3, 1, 4)
    gd = jax.nn.sigmoid(d_g.reshape(b, s, NSA_GROUPS, NSA_HPG, 3)).transpose(0, 2, 3, 1, 4)
    kvd = d_kv.reshape(b, s, 3, 2, NSA_GROUPS, NSA_DH).transpose(2, 3, 0, 4, 1, 5)
    y_d = merge_heads(nsa_attention(qd, gd, kvd, nsa_cmp_pe, nsa_cmp_w1, nsa_cmp_w2))

    ys = jnp.stack([y_a, y_b, y_c, y_d], axis=2)
    branch_out = jnp.einsum('bsnc,ncd->bsnd', ys, w_branch)
    gates = jax.nn.sigmoid(gate.reshape(b, s, N_BRANCH, D_MODEL))
    merged = jnp.einsum('bsnd,bsnd->bsd', gates, branch_out)
    return merged @ w_out


def conv_glu_mlp(h, w_up, conv_w, conv_b, w_down):
    s = h.shape[1]
    u = h @ w_up
    up = jnp.pad(u, ((0, 0), (CONV_WIDTH - 1, 0), (0, 0)))
    u = conv_b + sum(conv_w[k] * up[:, k:k + s] for k in range(CONV_WIDTH))
    a, g = jnp.split(u, 2, axis=-1)
    return (jax.nn.silu(a) * g) @ w_down


def setup_inputs(seed: int = 0) -> dict:
    key = jax.random.key(seed)
    ks = iter(jax.random.split(key, 32))
    L = DEPTH

    def nrm(shape, fan_in):
        return jax.random.normal(next(ks), shape, jnp.float32) * fan_in ** -0.5

    def gain(shape):
        return 1.0 + 0.02 * jax.random.normal(next(ks), shape, jnp.float32)

    def small(shape, scale):
        return scale * jax.random.normal(next(ks), shape, jnp.float32)

    return {
        'x': jax.random.normal(next(ks), (BATCH, SEQ, D_MODEL), jnp.float32),
        'norm_mix': gain((L, D_MODEL)),
        'w_in': nrm((L, D_MODEL, N_IN), D_MODEL),
        'diff_lambda': small((L, 4, DIFF_DH), 0.1),
        'diff_subln': gain((L, 2 * DIFF_DH)),
        'mla_norm_q': gain((L, MLA_Q_LORA)),
        'mla_w_uq': nrm((L, MLA_Q_LORA, MLA_HEADS * (MLA_NOPE + MLA_ROPE)), MLA_Q_LORA),
        'mla_norm_kv': gain((L, MLA_KV_LORA)),
        'mla_w_ukv': nrm((L, MLA_KV_LORA, MLA_HEADS * (MLA_NOPE + MLA_VDIM)), MLA_KV_LORA),
        'fox_b_f': 3.0 + small((L, FOX_HEADS), 0.5),
        'nsa_cmp_pe': small((L, 2, CMP_LEN, NSA_DH), 0.02),
        'nsa_cmp_w1': nrm((L, 2, CMP_LEN * NSA_DH, CMP_HIDDEN), CMP_LEN * NSA_DH),
        'nsa_cmp_w2': nrm((L, 2, CMP_HIDDEN, NSA_DH), CMP_HIDDEN),
        'w_branch': nrm((L, N_BRANCH, BRANCH_WIDTH, D_MODEL), BRANCH_WIDTH),
        'w_out': nrm((L, D_MODEL, D_MODEL), D_MODEL),
        'norm_ffn': gain((L, D_MODEL)),
        'w_up': nrm((L, D_MODEL, 2 * D_FF), D_MODEL),
        'conv_w': nrm((L, CONV_WIDTH, 2 * D_FF), CONV_WIDTH),
        'conv_b': small((L, 2 * D_FF), 0.02),
        'w_down': nrm((L, D_FF, D_MODEL), D_FF),
        'norm_final': gain((D_MODEL,)),
    }


def reference(x, norm_mix, w_in, diff_lambda, diff_subln, mla_norm_q, mla_w_uq, mla_norm_kv, mla_w_ukv,
              fox_b_f, nsa_cmp_pe, nsa_cmp_w1, nsa_cmp_w2, w_branch, w_out, norm_ffn, w_up, conv_w,
              conv_b, w_down, norm_final):
    for l in range(DEPTH):
        h = rms_norm(x, norm_mix[l])
        x = x + token_mixers(h, l, w_in[l], diff_lambda[l], diff_subln[l], mla_norm_q[l], mla_w_uq[l],
                             mla_norm_kv[l], mla_w_ukv[l], fox_b_f[l], nsa_cmp_pe[l], nsa_cmp_w1[l],
                             nsa_cmp_w2[l], w_branch[l], w_out[l])
        h = rms_norm(x, norm_ffn[l])
        x = x + conv_glu_mlp(h, w_up[l], conv_w[l], conv_b[l], w_down[l])
    return rms_norm(x, norm_final)
```

```cpp
#include <hip/hip_runtime.h>
#include <hip/hip_cooperative_groups.h>
#include <cstdio>
#include <cstdint>
namespace cg = cooperative_groups;

#define DI __device__ __forceinline__
#define LAS __attribute__((address_space(3)))
typedef unsigned short bf16_t;
typedef short bf16x8 __attribute__((ext_vector_type(8)));
typedef short s16x4 __attribute__((ext_vector_type(4)));
typedef float f32x4 __attribute__((ext_vector_type(4)));
typedef float f32x16 __attribute__((ext_vector_type(16)));
typedef unsigned u32x4 __attribute__((ext_vector_type(4)));
typedef unsigned u32x2 __attribute__((ext_vector_type(2)));
typedef float f32x2_t __attribute__((ext_vector_type(2)));
typedef __bf16 bf16x2_t __attribute__((ext_vector_type(2)));

DI unsigned cvtpk(float lo, float hi) { f32x2_t v = {lo, hi}; bf16x2_t b = __builtin_convertvector(v, bf16x2_t); return __builtin_bit_cast(unsigned, b); }
DI float bflo(unsigned u) { return __uint_as_float(u << 16); }
DI float bfhi(unsigned u) { return __uint_as_float(u & 0xffff0000u); }
DI float bf2f(bf16_t u) { return __uint_as_float(((unsigned)u) << 16); }
DI float sigmoidf_(float x) { return __builtin_amdgcn_rcpf(1.f + __builtin_amdgcn_exp2f(-1.4426950408889634f * x)); }
template <int M> DI unsigned swz_xor(unsigned v) { return (unsigned)__builtin_amdgcn_ds_swizzle((int)v, (M << 10) | 0x1f); }
DI float hsum32(float v) { auto rr = __builtin_amdgcn_permlane32_swap(__float_as_uint(v), __float_as_uint(v), false, false); return __uint_as_float(rr[0]) + __uint_as_float(rr[1]); }
DI unsigned hor32(unsigned v) { auto rr = __builtin_amdgcn_permlane32_swap(v, v, false, false); return rr[0] | rr[1]; }
DI float wave_sum(float v) {
    v += __uint_as_float(swz_xor<1>(__float_as_uint(v))); v += __uint_as_float(swz_xor<2>(__float_as_uint(v))); v += __uint_as_float(swz_xor<4>(__float_as_uint(v)));
    v += __uint_as_float(swz_xor<8>(__float_as_uint(v))); v += __uint_as_float(swz_xor<16>(__float_as_uint(v)));
    return hsum32(v);
}
DI unsigned wave_or(unsigned v) { v |= swz_xor<1>(v); v |= swz_xor<2>(v); v |= swz_xor<4>(v); v |= swz_xor<8>(v); v |= swz_xor<16>(v); return hor32(v); }

DI int fresh_tid(int wave0) { unsigned z_; asm volatile("v_mov_b32 %0, 0" : "=v"(z_)); return wave0 * 64 + (int)__builtin_amdgcn_mbcnt_hi(~0u, __builtin_amdgcn_mbcnt_lo(~0u, z_)); }

constexpr int SEQ = 4096, DM = 1024, NB = 8, TALL = NB * SEQ;
constexpr int BC = 4, TC = BC * SEQ, NCHUNK = 2;
constexpr int NIN = 9052, DFF = 2816;
constexpr int LDP = 3840;
constexpr int C_AQ = 0, C_AK = 512, C_BCQ = 1024, C_BCKV = 1280, C_CQ = 1536, C_CK = 2048, C_DQ = 2560, C_DKS = 3072, C_DKW = 3200,
              C_CMP = 3328, C_KR = 3584, C_CF = 3648, C_DG = 3656, C_GATE = 3840, N_RM = 7936, N_TR = 1280;
constexpr int C_YB = 1024;
constexpr int R_AV = 0, R_CV = 512, R_DVS = 1024, R_DVW = 1152;
constexpr float LOG2E = 1.4426950408889634f;
constexpr float EPS = 1e-6f;

constexpr size_t MiB = 1ull << 20;
constexpr size_t WS_CTL = 0;
constexpr size_t WS_WIN = 1 * MiB;
constexpr size_t WS_WUQ = 19 * MiB;
constexpr size_t WS_WUKV = WS_WUQ + 512 * 1024;
constexpr size_t WS_WBR = 20 * MiB;
constexpr size_t WS_WOUT = 24 * MiB;
constexpr size_t WS_WUP = 26 * MiB;
constexpr size_t WS_WDN = 37 * MiB;
constexpr size_t WS_WC1 = 43 * MiB;
constexpr size_t WS_WC2 = 44 * MiB;
constexpr size_t WS_H = 48 * MiB;
constexpr size_t WS_PRM = 80 * MiB;
constexpr size_t WS_GATES = 200 * MiB;
constexpr int LDVT = TC + 64;
constexpr size_t WS_VT = 328 * MiB;
constexpr size_t WS_QF = 369 * MiB;
constexpr size_t WS_KN = 393 * MiB;
constexpr size_t WS_MVT = 409 * MiB;
constexpr size_t WS_CKV = 426 * MiB;
constexpr size_t WS_HID = 435 * MiB;
constexpr size_t WS_KC = 436 * MiB;
constexpr size_t WS_VCT = WS_KC + 256 * 1024;
constexpr size_t WS_LOGF = WS_KC + 512 * 1024;
constexpr size_t WS_CUM = WS_KC + 768 * 1024;
constexpr size_t WS_MRG = 438 * MiB;
constexpr size_t WS_H8 = 470 * MiB;
constexpr size_t WS_WG8 = 486 * MiB;
constexpr size_t WS_END = 490 * MiB;
constexpr size_t WS_U = WS_PRM;
constexpr size_t WS_ACT = WS_PRM + 176 * MiB;
constexpr int CW_ATT = 16;
constexpr int CW_BAR = 2048;
constexpr int CF_LAM = 1024;
constexpr int CF_PEB = 1088;

struct Params {
    const float* in[21];
    float* out;
    unsigned char* ws;
};

namespace pg8 {
constexpr int BM = 256, BK = 64, HALF = 128, HTB = HALF * BK * 2, STAGE_BYTES = 8 * HTB, NXCD = 8, WGM = 8;
DI int lds_byte(int r, int c) { const int st = (r >> 4) * 2 + (c >> 5), rr = r & 15, cc = c & 31, ob = rr * 64 + cc * 2; return st * 1024 + (ob ^ (((ob >> 9) & 1) << 5)); }
DI void stage_rc(int b, int& R, int& C) { const int st = b / 1024, sb = b % 1024, swz = sb ^ (((sb >> 9) & 1) << 5); R = (st >> 1) * 16 + swz / 64; C = (st & 1) * 32 + (swz % 64) / 2; }
DI int perm32(int rho) { const int n = rho >> 4, i = rho & 15; return 8 * (i >> 2) + 4 * n + (i & 3); }
struct Unit { int pm, pn; };
struct Gemm { const bf16_t* A; const bf16_t* Bt; int M, N, K, lda, ldb; };
struct StaticOrder {
    int nM, nN, nwg, G, c;
    DI void init(int M, int N, int G_, int c_) { nM = M / BM; nN = N / BM; nwg = nM * nN; G = G_; c = c_; }
    DI bool next(int i, Unit& u) const {
        const long L = (long)i * G + c; if (L >= nwg) return false;
        int wgid = (int)L; { const int q = nwg / NXCD, r = nwg % NXCD, xcd = wgid % NXCD, off = wgid / NXCD; wgid = (xcd < r ? xcd * (q + 1) : r * (q + 1) + (xcd - r) * q) + off; }
        const int nig = WGM * nN, gid = wgid / nig, fm = gid * WGM, gsz = (nM - fm) < WGM ? (nM - fm) : WGM;
        u.pm = fm + ((wgid % nig) % gsz); u.pn = (wgid % nig) / gsz; return true;
    }
};

enum { M_PLAIN = 0, M_GATE8, M_INRM, M_QF, M_CMP1, M_CMP2, M_MERGE, M_OUT, M_DOWN };
struct Epi {
    int mode, aux;
    bf16_t* o0; int ld0;
    bf16_t* o1;
    bf16_t* o2;
    float* f0;
    const float* f1;
    DI void rope8(float (&v)[8], int pos, int i0) const {
#pragma unroll
        for (int p = 0; p < 4; ++p) {
            const float invf = __builtin_amdgcn_exp2f(-(float)(i0 + p) * 0.4152410118609203f);
            const float ang = (float)pos * invf; float rev = ang * 0.15915494309189535f; rev -= rintf(rev);
            const float cs = __builtin_amdgcn_cosf(rev), sn = __builtin_amdgcn_sinf(rev);
            const float a = v[2 * p], b = v[2 * p + 1];
            v[2 * p] = a * cs - b * sn; v[2 * p + 1] = b * cs + a * sn;
        }
    }
    DI void st8(bf16_t* p, const float (&v)[8]) const { u32x4 w; w.x = cvtpk(v[0], v[1]); w.y = cvtpk(v[2], v[3]); w.z = cvtpk(v[4], v[5]); w.w = cvtpk(v[6], v[7]); *(u32x4*)p = w; }
    DI void emit(int row, int col0, float (&v)[8]) const {
        switch (mode) {
        case M_PLAIN: st8(o0 + (size_t)row * ld0 + col0, v); break;
        case M_GATE8: {
#pragma unroll
            for (int j = 0; j < 8; ++j) v[j] = sigmoidf_(v[j] * (1.f / 1024.f)) * 255.f;
            unsigned w0 = __builtin_amdgcn_cvt_pk_u8_f32(v[0], 0, 0u); w0 = __builtin_amdgcn_cvt_pk_u8_f32(v[1], 1, w0); w0 = __builtin_amdgcn_cvt_pk_u8_f32(v[2], 2, w0); w0 = __builtin_amdgcn_cvt_pk_u8_f32(v[3], 3, w0);
            unsigned w1 = __builtin_amdgcn_cvt_pk_u8_f32(v[4], 0, 0u); w1 = __builtin_amdgcn_cvt_pk_u8_f32(v[5], 1, w1); w1 = __builtin_amdgcn_cvt_pk_u8_f32(v[6], 2, w1); w1 = __builtin_amdgcn_cvt_pk_u8_f32(v[7], 3, w1);
            *(u32x2*)((unsigned char*)o1 + (size_t)row * 4096 + col0) = (u32x2){w0, w1};
        } break;
        case M_INRM: {
            if (col0 >= C_GATE) {
#pragma unroll
                for (int j = 0; j < 8; ++j) v[j] = sigmoidf_(v[j]);
                st8(o1 + (size_t)row * 4096 + (col0 - C_GATE), v);
            } else if (col0 < C_CMP) {
                const float qs = (col0 < C_AK || (col0 >= C_DQ && col0 < C_DKS)) ? 0.125f * LOG2E : (col0 >= C_CQ && col0 < C_CK) ? 0.08838834764831845f * LOG2E : 1.f;
#pragma unroll
                for (int j = 0; j < 8; ++j) v[j] *= qs;
                st8(o0 + (size_t)row * LDP + col0, v); }
            else if (col0 < C_KR) {
                const int cc = col0 - C_CMP, kvsel = cc >> 7, g = (cc >> 6) & 1, d0 = cc & 63, b = row >> 12, s = row & 4095;
                st8(o2 + ((size_t)((kvsel * 4 + b) * 2 + g) * SEQ + s) * 64 + d0, v);
            } else if (col0 < C_CF) { rope8(v, row & 4095, (col0 - C_KR) >> 1); st8(o0 + (size_t)row * LDP + col0, v); }
            else if (col0 == C_CF) {
                f32x4 o;
#pragma unroll
                for (int j = 0; j < 4; ++j) { const float x = v[j] + f1[j]; const float e = __expf(-fabsf(x)); float r = -__logf(1.f + e); if (x < 0.f) r += x; o[j] = r; }
                *(f32x4*)(f0 + (size_t)row * 4) = o;
            } else if (col0 < 3680) {
#pragma unroll
                for (int j = 0; j < 8; ++j) v[j] = sigmoidf_(v[j]);
                st8(o0 + (size_t)row * LDP + col0, v);
            }
        } break;
        case M_QF: { const int j = col0 % 192; if (j >= 128) rope8(v, row & 4095, (j - 128) >> 1);
#pragma unroll
            for (int i = 0; i < 8; ++i) v[i] *= 0.07216878364870322f * LOG2E;
            st8(o0 + (size_t)row * 768 + col0, v); } break;
        case M_CMP1: {
            const int kvsel = row >> 11;
            if ((col0 >> 7) == kvsel) { const int j = col0 & 127;
#pragma unroll
                for (int i = 0; i < 8; ++i) { const float x = v[i] + f1[kvsel * 128 + j + i]; const float u = 0.7978845608028654f * (x + 0.044715f * x * x * x);
                    const float t = 1.f - 2.f / (1.f + __expf(2.f * u)); v[i] = 0.5f * x * (1.f + t); }
                st8(o0 + (size_t)row * 128 + j, v); }
        } break;
        case M_CMP2: {
            const int kvsel = row >> 11, bg = (row >> 8) & 7, c = row & 255;
            if (kvsel == 0 && col0 < 64) st8(o0 + ((size_t)bg * 256 + c) * 64 + col0, v);
            else if (kvsel == 1 && col0 >= 64 && col0 < 128) {
#pragma unroll
                for (int i = 0; i < 8; ++i) o1[((size_t)bg * 64 + (col0 - 64 + i)) * 256 + c] = (bf16_t)(cvtpk(v[i], 0.f) & 0xffffu);
            }
        } break;
        case M_MERGE: {
            const u32x2 g = *(const u32x2*)((const unsigned char*)o1 + (size_t)row * 4096 + aux * 1024 + col0);
            bf16_t* mp = o0 + (size_t)row * 1024 + col0;
#pragma unroll
            for (int j = 0; j < 8; ++j) v[j] *= (1.f / 255.f);
            float m[8] = {0.f, 0.f, 0.f, 0.f, 0.f, 0.f, 0.f, 0.f};
            if (aux > 0) { const u32x4 o = *(const u32x4*)mp; m[0] = bflo(o.x); m[1] = bfhi(o.x); m[2] = bflo(o.y); m[3] = bfhi(o.y); m[4] = bflo(o.z); m[5] = bfhi(o.z); m[6] = bflo(o.w); m[7] = bfhi(o.w); }
            v[0] = m[0] + (float)(g.x & 0xffu) * v[0]; v[1] = m[1] + (float)((g.x >> 8) & 0xffu) * v[1]; v[2] = m[2] + (float)((g.x >> 16) & 0xffu) * v[2]; v[3] = m[3] + (float)(g.x >> 24) * v[3];
            v[4] = m[4] + (float)(g.y & 0xffu) * v[4]; v[5] = m[5] + (float)((g.y >> 8) & 0xffu) * v[5]; v[6] = m[6] + (float)((g.y >> 16) & 0xffu) * v[6]; v[7] = m[7] + (float)(g.y >> 24) * v[7];
            st8(mp, v);
        } break;
        case M_OUT: case M_DOWN: {
            const float* src = (mode == M_OUT) ? f1 : f0; const size_t off = (size_t)row * DM + col0;
            const f32x4 a = *(const f32x4*)(src + off), b = *(const f32x4*)(src + off + 4);
            *(f32x4*)(f0 + off) = (f32x4){a.x + v[0], a.y + v[1], a.z + v[2], a.w + v[3]};
            *(f32x4*)(f0 + off + 4) = (f32x4){b.x + v[4], b.y + v[5], b.z + v[6], b.w + v[7]};
        } break;
        }
    }
    DI void operator()(const f32x4 (&acc)[2][2][4][2], const Unit& u, int wr, int wc, int fr, int fq) const {
#pragma unroll
        for (int ai = 0; ai < 2; ++ai)
#pragma unroll
            for (int m = 0; m < 4; ++m) {
                const int row = u.pm * BM + ai * HALF + wr * 64 + m * 16 + fr;
#pragma unroll
                for (int bj = 0; bj < 2; ++bj) {
                    const int col0 = u.pn * BM + bj * HALF + wc * 32 + 8 * fq;
                    const f32x4 a = acc[ai][bj][m][0], b = acc[ai][bj][m][1];
                    float v[8] = {a.x, a.y, a.z, a.w, b.x, b.y, b.z, b.w};
                    emit(row, col0, v);
                    if (bj == 1 && (m & 1)) asm volatile("" ::: "memory");
                }
            }
    }
};

typedef int v4i_t __attribute__((ext_vector_type(4)));
typedef int v8i_t __attribute__((ext_vector_type(8)));
typedef long v2l_t __attribute__((ext_vector_type(2)));
template <bool FP8>
DI void gemm_phase(LAS unsigned char* lds, const Gemm g, const StaticOrder& S, const Epi& E, int tid) {
    asm volatile("" : "+v"(tid));
    const int wid = __builtin_amdgcn_readfirstlane(tid >> 6), lane = tid & 63, wr = wid >> 2, wc = wid & 3, fr = lane & 15, fq = lane >> 4;
    const int K = g.K, nt = K / BK;
    unsigned voffA[2], voffB[2];
#pragma unroll
    for (int i = 0; i < 2; ++i) { int R, C; stage_rc(tid * 16 + i * 8192, R, C); const int Rb = (R & ~31) + perm32(R & 31);
        voffA[i] = (unsigned)(R * g.lda + C) * 2u; voffB[i] = (unsigned)(Rb * g.ldb + C) * 2u; }
    const unsigned kstep = (unsigned)(BK * 2);
    const unsigned hA = (unsigned)HALF * g.lda * 2u, hB = (unsigned)HALF * g.ldb * 2u;
    const unsigned tA = 2u * hA, tB = 2u * hB;
    const char* const Ab = (const char*)g.A; const char* const Bb = (const char*)g.Bt;
    const unsigned ldsw = (unsigned)wid * 1024u;
    const int aoff = lds_byte(wr * 64 + fr, fq * 8), boff = lds_byte(wc * 32 + fr, fq * 8);
#define PG8_SA(b, h) (((b) * 2 + (h)) * HTB)
#define PG8_SB(b, h) ((4 + (b) * 2 + (h)) * HTB)
#define PG8_STAGE(bufoff, gbase, voff) do { _Pragma("unroll") for (int _i = 0; _i < 2; ++_i) \
        __builtin_amdgcn_global_load_lds((const unsigned*)((gbase) + (voff)[_i]), (LAS unsigned*)(lds + (bufoff) + ldsw + _i * 8192), 16, 0, 0); } while (0)
#define PG8_LD8(addr_) __builtin_shufflevector(*(const LAS v4i_t*)(addr_), *(const LAS v4i_t*)((addr_) + 1024), 0, 1, 2, 3, 4, 5, 6, 7)
#define PG8_LDA(dst, b, h) do { _Pragma("unroll") for (int m = 0; m < 4; ++m) { if constexpr (FP8) dst##8[m] = PG8_LD8(lds + PG8_SA(b, h) + aoff + m * 2048); \
        else { _Pragma("unroll") for (int k = 0; k < 2; ++k) dst[m][k] = *(const LAS bf16x8*)(lds + PG8_SA(b, h) + aoff + m * 2048 + k * 1024); } } } while (0)
#define PG8_LDB(dst, b, h) do { _Pragma("unroll") for (int n = 0; n < 2; ++n) { if constexpr (FP8) dst##8[n] = PG8_LD8(lds + PG8_SB(b, h) + boff + n * 2048); \
        else { _Pragma("unroll") for (int k = 0; k < 2; ++k) dst[n][k] = *(const LAS bf16x8*)(lds + PG8_SB(b, h) + boff + n * 2048 + k * 1024); } } } while (0)
#define PG8_MMA(ai, bj, At, Bt) do { __builtin_amdgcn_s_setprio(1); \
        if constexpr (FP8) { _Pragma("unroll") for (int m = 0; m < 4; ++m) _Pragma("unroll") for (int n = 0; n < 2; ++n) \
            acc[ai][bj][m][n] = __builtin_amdgcn_mfma_scale_f32_16x16x128_f8f6f4(Bt##8[n], At##8[m], acc[ai][bj][m][n], 0, 0, 0, 0x7f7f7f7f, 0, 0x7f7f7f7f); } \
        else { _Pragma("unroll") for (int m = 0; m < 4; ++m) _Pragma("unroll") for (int n = 0; n < 2; ++n) _Pragma("unroll") for (int k = 0; k < 2; ++k) \
            acc[ai][bj][m][n] = __builtin_amdgcn_mfma_f32_16x16x32_bf16(Bt[n][k], At[m][k], acc[ai][bj][m][n], 0, 0, 0); } __builtin_amdgcn_s_setprio(0); } while (0)
#define PG8_WAIT_V(n) asm volatile("s_waitcnt vmcnt(" #n ")" ::: "memory")
#define PG8_WAIT_L(n) asm volatile("s_waitcnt lgkmcnt(" #n ")" ::: "memory")
#define PG8_BAR __builtin_amdgcn_s_barrier()
#define PG8_SCHED __builtin_amdgcn_sched_barrier(0)
    Unit cur, nxt; int ui = 0;
    if (!S.next(0, cur)) return;
    f32x4 acc[2][2][4][2];
#pragma unroll
    for (int a = 0; a < 2; ++a)
#pragma unroll
        for (int b = 0; b < 2; ++b)
#pragma unroll
            for (int m = 0; m < 4; ++m)
#pragma unroll
                for (int n = 0; n < 2; ++n) acc[a][b][m][n] = (f32x4){0.f, 0.f, 0.f, 0.f};
    bf16x8 At[4][2], B0[2][2], B1[2][2];
    v8i_t At8[4], B08[2], B18[2];
    unsigned cA = (unsigned)cur.pm * tA, cB = (unsigned)cur.pn * tB;
#define GA(o) (Ab + (o))
#define GB(o) (Bb + (o))
    PG8_STAGE(PG8_SB(0, 0), GB(cB), voffB); PG8_STAGE(PG8_SB(0, 1), GB(cB + hB), voffB); PG8_STAGE(PG8_SA(0, 0), GA(cA), voffA); PG8_STAGE(PG8_SA(0, 1), GA(cA + hA), voffA);
    if (wr == 1) PG8_BAR;
    PG8_WAIT_V(2); PG8_BAR;
    PG8_STAGE(PG8_SB(1, 0), GB(cB + kstep), voffB); PG8_STAGE(PG8_SA(1, 0), GA(cA + kstep), voffA); PG8_STAGE(PG8_SB(1, 1), GB(cB + hB + kstep), voffB);
    PG8_WAIT_V(6); PG8_BAR;
    for (;;) {
        const bool has_next = S.next(ui + 1, nxt);
        const unsigned nA = has_next ? (unsigned)nxt.pm * tA : cA, nB = has_next ? (unsigned)nxt.pn * tB : cB;
        for (int t = 0; t < nt; t += 2) {
            const bool last = (t == nt - 2);
            const unsigned a1 = cA + (unsigned)(t + 1) * kstep;
            const unsigned a2 = last ? nA : cA + (unsigned)(t + 2) * kstep, b2 = last ? nB : cB + (unsigned)(t + 2) * kstep;
            const unsigned a3 = a2 + kstep, b3 = b2 + kstep;
            PG8_LDB(B0, 0, 0); PG8_LDB(B1, 0, 1); PG8_SCHED; PG8_LDA(At, 0, 0); PG8_STAGE(PG8_SA(1, 1), GA(a1 + hA), voffA);
            PG8_WAIT_V(8); PG8_WAIT_L(0); PG8_BAR; PG8_MMA(0, 0, At, B0); PG8_MMA(0, 1, At, B1); PG8_BAR; PG8_SCHED;
            PG8_LDA(At, 0, 1); PG8_STAGE(PG8_SB(0, 0), GB(b2), voffB); PG8_STAGE(PG8_SB(0, 1), GB(b2 + hB), voffB); PG8_STAGE(PG8_SA(0, 0), GA(a2), voffA);
            PG8_WAIT_V(8); PG8_WAIT_L(0); PG8_BAR; PG8_MMA(1, 0, At, B0); PG8_MMA(1, 1, At, B1); PG8_BAR; PG8_SCHED;
            PG8_LDB(B0, 1, 0); PG8_LDB(B1, 1, 1); PG8_SCHED; PG8_LDA(At, 1, 0); PG8_STAGE(PG8_SA(0, 1), GA(a2 + hA), voffA);
            PG8_WAIT_V(8); PG8_WAIT_L(0); PG8_BAR; PG8_MMA(0, 0, At, B0); PG8_MMA(0, 1, At, B1); PG8_BAR; PG8_SCHED;
            PG8_LDA(At, 1, 1); PG8_STAGE(PG8_SB(1, 0), GB(b3), voffB); PG8_STAGE(PG8_SB(1, 1), GB(b3 + hB), voffB); PG8_STAGE(PG8_SA(1, 0), GA(a3), voffA);
            PG8_WAIT_V(8); PG8_WAIT_L(0); PG8_BAR; PG8_MMA(1, 0, At, B0); PG8_MMA(1, 1, At, B1); PG8_BAR; PG8_SCHED;
        }
        if (wr == 0) PG8_BAR;
        E(acc, cur, wr, wc, fr, fq);
        if (!has_next) break;
#pragma unroll
        for (int a = 0; a < 2; ++a)
#pragma unroll
            for (int b = 0; b < 2; ++b)
#pragma unroll
                for (int m = 0; m < 4; ++m)
#pragma unroll
                    for (int n = 0; n < 2; ++n) acc[a][b][m][n] = (f32x4){0.f, 0.f, 0.f, 0.f};
        cur = nxt; cA = nA; cB = nB; ++ui;
        if (wr == 1) PG8_BAR;
    }
    PG8_WAIT_V(0);
    PG8_BAR;
#undef GA
#undef GB
#undef PG8_SA
#undef PG8_SB
#undef PG8_STAGE
#undef PG8_LDA
#undef PG8_LD8
#undef PG8_LDB
#undef PG8_MMA
#undef PG8_WAIT_V
#undef PG8_WAIT_L
#undef PG8_BAR
#undef PG8_SCHED
}
}

DI unsigned pk4_fp8(float a, float b, float c, float d) {
    float mx; asm volatile("v_mov_b32 %0, 0x43e00000" : "=v"(mx));
    a = __builtin_fminf(__builtin_fmaxf(a, -mx), mx); b = __builtin_fminf(__builtin_fmaxf(b, -mx), mx); c = __builtin_fminf(__builtin_fmaxf(c, -mx), mx); d = __builtin_fminf(__builtin_fmaxf(d, -mx), mx);
    int w = __builtin_amdgcn_cvt_pk_fp8_f32(a, b, 0, false); w = __builtin_amdgcn_cvt_pk_fp8_f32(c, d, w, true); return (unsigned)w; }
DI int map_in(int n) {
    if (n < 1024) return n;
    if (n < 1280) return 1536 + (n - 1024);
    if (n < 1536) return 1792 + (n - 1280);
    if (n < 2048) return 2112 + (n - 1536);
    if (n < 2560) return 2624 + (n - 2048);
    if (n < 3072) return 3652 + (n - 2560);
    if (n < 3200) return 4420 + (n - 3072);
    if (n < 3328) return 4676 + (n - 3200);
    if (n < 3456) return 4164 + (n - 3328);
    if (n < 3584) return 4292 + (n - 3456);
    if (n < 3648) { const int j = n - 3584; return 2048 + (j >> 1) + ((j & 1) ? 32 : 0); }
    if (n < 3652) return n;
    if (n < 3656) return -1;
    if (n < 3680) return 4932 + (n - 3656);
    if (n < 3840) return -1;
    if (n < 7936) return 4956 + (n - 3840);
    n -= 7936;
    if (n < 512) return 1024 + n;
    if (n < 1024) return 3136 + (n - 512);
    if (n < 1152) return 4548 + (n - 1024);
    return 4804 + (n - 1152);
}
DI int map_col(int mapid, int n) {
    switch (mapid) {
    case 1: return map_in(n);
    case 2: { const int h = n / 192, j = n % 192; if (j < 128) return n; const int jj = j - 128; return h * 192 + 128 + (jj >> 1) + ((jj & 1) ? 32 : 0); }
    case 3: { if (n < 512) { return (n >> 7) * 256 + (n & 127); } const int m = n - 512; return (m >> 7) * 256 + 128 + (m & 127); }
    default: return n;
    }
}
DI void tr_item(const float* W, int ldw, int K, bf16_t* WT, int nblk, int item, int mapid, LAS float* scr, int lane) {
    const int kb = item / nblk, nb = item % nblk, k0 = 64 * kb, n0 = 32 * nb;
    const int sc = map_col(mapid, n0 + (lane & 31));
    float tv[32];
#pragma unroll
    for (int i = 0; i < 32; ++i) { const int kk = 2 * i + (lane >> 5); tv[i] = (sc >= 0) ? W[(size_t)(k0 + kk) * ldw + sc] : 0.f; }
#pragma unroll
    for (int i = 0; i < 32; ++i) { const int kk = 2 * i + (lane >> 5); scr[kk * 33 + (lane & 31)] = tv[i]; }
    asm volatile("s_waitcnt lgkmcnt(0)" ::: "memory");
    const int c = lane & 7;
#pragma unroll
    for (int j = 0; j < 4; ++j) { const int n = (lane >> 3) + 8 * j; const LAS float* s = scr + (8 * c) * 33 + n;
        u32x4 o; o.x = cvtpk(s[0 * 33], s[1 * 33]); o.y = cvtpk(s[2 * 33], s[3 * 33]); o.z = cvtpk(s[4 * 33], s[5 * 33]); o.w = cvtpk(s[6 * 33], s[7 * 33]);
        *(u32x4*)(WT + (size_t)(n0 + n) * K + k0 + 8 * c) = o; }
    asm volatile("s_waitcnt lgkmcnt(0)" ::: "memory");
}

DI void tr_item_fp8(const float* W, int ldw, int K, unsigned char* WT, int nblk, int item, int col_off, float sc, LAS float* scr, int lane) {
    const int kb = item / nblk, nb = item % nblk, k0 = 64 * kb, n0 = 32 * nb;
    float tv[32];
#pragma unroll
    for (int i = 0; i < 32; ++i) { const int kk = 2 * i + (lane >> 5); tv[i] = W[(size_t)(k0 + kk) * ldw + col_off + n0 + (lane & 31)]; }
#pragma unroll
    for (int i = 0; i < 32; ++i) { const int kk = 2 * i + (lane >> 5); scr[kk * 33 + (lane & 31)] = tv[i] * sc; }
    asm volatile("s_waitcnt lgkmcnt(0)" ::: "memory");
    const int c = lane & 7;
#pragma unroll
    for (int j = 0; j < 4; ++j) { const int n = (lane >> 3) + 8 * j; const LAS float* s = scr + (8 * c) * 33 + n;
        u32x2 o; o.x = pk4_fp8(s[0 * 33], s[1 * 33], s[2 * 33], s[3 * 33]); o.y = pk4_fp8(s[4 * 33], s[5 * 33], s[6 * 33], s[7 * 33]);
        *(u32x2*)(WT + (size_t)(n0 + n) * K + k0 + 8 * c) = o; }
    asm volatile("s_waitcnt lgkmcnt(0)" ::: "memory");
}
DI void prologue_weights(const Params& p, int l, LAS unsigned char* lds, int gw, int ngw, int wave, int lane) {
    LAS float* scr = (LAS float*)(lds + wave * 16384);
    unsigned char* ws = p.ws;
    const float* w_in = p.in[2] + (size_t)l * DM * NIN;
    const float* w_uq = p.in[6] + (size_t)l * 256 * 768;
    const float* w_ukv = p.in[8] + (size_t)l * 256 * 1024;
    const float* w_br = p.in[13] + (size_t)l * 4 * 512 * 1024;
    const float* w_out = p.in[14] + (size_t)l * DM * DM;
    const float* w_up = p.in[16] + (size_t)l * DM * 2 * DFF;
    const float* w_dn = p.in[19] + (size_t)l * DFF * DM;
    const float* w_c1 = p.in[11] + (size_t)l * 2 * 2048 * 128;
    constexpr int I_IN = 16 * 288, I_UQ = 4 * 24, I_UKV = 4 * 32, I_BR = 8 * 32, I_OUT = 16 * 32, I_UP = 16 * 176, I_DN = 44 * 32, I_C1 = 32 * 4;
    constexpr int I_C2 = 2 * 2;
    const float* w_c2 = p.in[12] + (size_t)l * 2 * 128 * 64;
    constexpr int I_G8 = 16 * 128;
    constexpr int NITEMS = I_IN + I_UQ + I_UKV + 4 * I_BR + I_OUT + I_UP + I_DN + 2 * I_C1 + 2 * I_C2 + I_G8;
    for (int it = gw; it < NITEMS; it += ngw) {
        int r = it;
        if (r < I_IN) { const int nb_ = r % 288; if (nb_ < 120 || nb_ >= 248) tr_item(w_in, NIN, DM, (bf16_t*)(ws + WS_WIN), 288, r, 1, scr, lane); continue; } r -= I_IN;
        if (r < I_UQ) { tr_item(w_uq, 768, 256, (bf16_t*)(ws + WS_WUQ), 24, r, 2, scr, lane); continue; } r -= I_UQ;
        if (r < I_UKV) { tr_item(w_ukv, 1024, 256, (bf16_t*)(ws + WS_WUKV), 32, r, 3, scr, lane); continue; } r -= I_UKV;
        if (r < 4 * I_BR) { const int n = r / I_BR; tr_item(w_br + (size_t)n * 512 * 1024, 1024, 512, (bf16_t*)(ws + WS_WBR) + (size_t)n * 1024 * 512, 32, r % I_BR, 0, scr, lane); continue; } r -= 4 * I_BR;
        if (r < I_OUT) { tr_item(w_out, DM, DM, (bf16_t*)(ws + WS_WOUT), 32, r, 0, scr, lane); continue; } r -= I_OUT;
        if (r < I_UP) { tr_item(w_up, 2 * DFF, DM, (bf16_t*)(ws + WS_WUP), 176, r, 0, scr, lane); continue; } r -= I_UP;
        if (r < I_DN) { tr_item(w_dn, DM, DFF, (bf16_t*)(ws + WS_WDN), 32, r, 0, scr, lane); continue; } r -= I_DN;
        if (r < 2 * I_C1) { const int n = r / I_C1; tr_item(w_c1 + (size_t)n * 2048 * 128, 128, 2048, (bf16_t*)(ws + WS_WC1) + (size_t)n * 128 * 2048, 4, r % I_C1, 0, scr, lane); continue; } r -= 2 * I_C1;
        if (r < 2 * I_C2) { const int n = r / I_C2; tr_item(w_c2 + (size_t)n * 128 * 64, 64, 128, (bf16_t*)(ws + WS_WC2) + (size_t)n * 64 * 128, 2, r % I_C2, 0, scr, lane); continue; } r -= 2 * I_C2;
        tr_item_fp8(w_in, NIN, DM, ws + WS_WG8, 128, r, 4956, 64.f, scr, lane);
    }
    float* ctlf = (float*)(ws + WS_CTL);
    const float* pe = p.in[10] + (size_t)l * 2 * 2048;
    for (int o = gw; o < 256; o += ngw) {
        const int kvsel = o >> 7, j = o & 127; float s = 0.f;
#pragma unroll 8
        for (int k = lane; k < 2048; k += 64) s += pe[kvsel * 2048 + k] * w_c1[((size_t)kvsel * 2048 + k) * 128 + j];
        s = wave_sum(s); if (lane == 0) ctlf[CF_PEB + o] = s;
    }
    if (gw == ngw - 1) {
        const float* dl = p.in[3] + (size_t)l * 4 * 64;
        const float a = wave_sum(dl[lane] * dl[64 + lane]), b = wave_sum(dl[128 + lane] * dl[192 + lane]);
        int ll = l; asm volatile("" : "+s"(ll));
        const float lam_init = (ll == 0) ? 0.2f : 0.35550906759f;
        if (lane == 0) { ctlf[CF_LAM] = expf(a) - expf(b) + lam_init; ctlf[CF_LAM + 1] = lam_init; }
    }
}

DI void norm_row_bf16(const float* xr, const float* g, bf16_t* orow, int lane) {
    f32x4 v[4]; float s = 0.f;
#pragma unroll
    for (int j = 0; j < 4; ++j) { v[j] = ((const f32x4*)xr)[64 * j + lane]; s += (v[j].x * v[j].x + v[j].y * v[j].y) + (v[j].z * v[j].z + v[j].w * v[j].w); }
    const float rs = 1.f / sqrtf(wave_sum(s) * (1.f / DM) + EPS);
#pragma unroll
    for (int j = 0; j < 4; ++j) { const f32x4 gg = ((const f32x4*)g)[64 * j + lane];
        u32x2 o; o.x = cvtpk(v[j].x * rs * gg.x, v[j].y * rs * gg.y); o.y = cvtpk(v[j].z * rs * gg.z, v[j].w * rs * gg.w);
        ((u32x2*)orow)[64 * j + lane] = o; }
}
DI void norm_row_f32(float* xr, const float* g, int lane) {
    f32x4 v[4]; float s = 0.f;
#pragma unroll
    for (int j = 0; j < 4; ++j) { v[j] = ((const f32x4*)xr)[64 * j + lane]; s += (v[j].x * v[j].x + v[j].y * v[j].y) + (v[j].z * v[j].z + v[j].w * v[j].w); }
    const float rs = 1.f / sqrtf(wave_sum(s) * (1.f / DM) + EPS);
#pragma unroll
    for (int j = 0; j < 4; ++j) { const f32x4 gg = ((const f32x4*)g)[64 * j + lane];
        ((f32x4*)xr)[64 * j + lane] = (f32x4){v[j].x * rs * gg.x, v[j].y * rs * gg.y, v[j].z * rs * gg.z, v[j].w * rs * gg.w}; }
}
DI void norm256_inplace_x4(bf16_t* const (&r)[4], const float* const (&g)[4], int lane) {
    u32x2 w[4];
#pragma unroll
    for (int k = 0; k < 4; ++k) w[k] = ((const u32x2*)r[k])[lane];
#pragma unroll
    for (int k = 0; k < 4; ++k) {
        const float a = bflo(w[k].x), b = bfhi(w[k].x), c = bflo(w[k].y), d = bfhi(w[k].y);
        const float rs = 1.f / sqrtf(wave_sum((a * a + b * b) + (c * c + d * d)) * (1.f / 256.f) + EPS);
        const f32x4 gg = ((const f32x4*)g[k])[lane];
        u32x2 o; o.x = cvtpk(a * rs * gg.x, b * rs * gg.y); o.y = cvtpk(c * rs * gg.z, d * rs * gg.w);
        ((u32x2*)r[k])[lane] = o;
    }
}
DI void norm_row_bf16_x2(const float* x0, const float* x1, const float* g, bf16_t* o0, bf16_t* o1, int lane, unsigned char* q0 = nullptr, unsigned char* q1 = nullptr) {
    f32x4 v[2][4]; float s[2] = {0.f, 0.f};
#pragma unroll
    for (int k = 0; k < 2; ++k)
#pragma unroll
        for (int j = 0; j < 4; ++j) v[k][j] = ((const f32x4*)(k ? x1 : x0))[64 * j + lane];
#pragma unroll
    for (int k = 0; k < 2; ++k)
#pragma unroll
        for (int j = 0; j < 4; ++j) s[k] += (v[k][j].x * v[k][j].x + v[k][j].y * v[k][j].y) + (v[k][j].z * v[k][j].z + v[k][j].w * v[k][j].w);
#pragma unroll
    for (int k = 0; k < 2; ++k) {
        const float rs = 1.f / sqrtf(wave_sum(s[k]) * (1.f / DM) + EPS);
#pragma unroll
        for (int j = 0; j < 4; ++j) { const f32x4 gg = ((const f32x4*)g)[64 * j + lane];
            u32x2 o; o.x = cvtpk(v[k][j].x * rs * gg.x, v[k][j].y * rs * gg.y); o.y = cvtpk(v[k][j].z * rs * gg.z, v[k][j].w * rs * gg.w);
            ((u32x2*)(k ? o1 : o0))[64 * j + lane] = o;
            if (q0) ((unsigned*)(k ? q1 : q0))[64 * j + lane] = pk4_fp8(v[k][j].x * rs * gg.x * 16.f, v[k][j].y * rs * gg.y * 16.f, v[k][j].z * rs * gg.z * 16.f, v[k][j].w * rs * gg.w * 16.f); }
    }
}
DI void norm256_inplace(bf16_t* r, const float* g, int lane) {
    const u32x2 w = ((const u32x2*)r)[lane];
    float a = bflo(w.x), b = bfhi(w.x), c = bflo(w.y), d = bfhi(w.y);
    const float rs = 1.f / sqrtf(wave_sum((a * a + b * b) + (c * c + d * d)) * (1.f / 256.f) + EPS);
    const f32x4 gg = ((const f32x4*)g)[lane];
    u32x2 o; o.x = cvtpk(a * rs * gg.x, b * rs * gg.y); o.y = cvtpk(c * rs * gg.z, d * rs * gg.w);
    ((u32x2*)r)[lane] = o;
}
DI void cumsum_block(const float* logf  , float* cum  , int bh, int tid, LAS float* red  ) {
    const int b = bh >> 2, h = bh & 3, lane = tid & 63, wave = tid >> 6;
    const float* src = logf + ((size_t)b * SEQ + tid * 8) * 4 + h;
    float v[8]; float s = 0.f;
#pragma unroll
    for (int i = 0; i < 8; ++i) { v[i] = src[i * 4]; }
#pragma unroll
    for (int i = 0; i < 8; ++i) { s += v[i]; v[i] = s; }
    float inc = s;
#pragma unroll
    for (int o = 1; o < 64; o <<= 1) { const float t = __uint_as_float((unsigned)__builtin_amdgcn_ds_bpermute((lane - o) << 2, (int)__float_as_uint(inc))); if (lane >= o) inc += t; }
    if (lane == 63) red[wave] = inc;
    __syncthreads();
    float base = inc - s;
#pragma unroll
    for (int w = 0; w < 8; ++w) base += (w < wave) ? red[w] : 0.f;
    float* dst = cum + (size_t)bh * SEQ + tid * 8;
    *(f32x4*)dst = (f32x4){-(base + v[0]) * LOG2E, -(base + v[1]) * LOG2E, -(base + v[2]) * LOG2E, -(base + v[3]) * LOG2E};
    *(f32x4*)(dst + 4) = (f32x4){-(base + v[4]) * LOG2E, -(base + v[5]) * LOG2E, -(base + v[6]) * LOG2E, -(base + v[7]) * LOG2E};
    __syncthreads();
}
DI void cmp2_phase(const Params& p, int l, int gtid, int gthreads) {
    const bf16_t* hid = (const bf16_t*)(p.ws + WS_HID);
    bf16_t* kc = (bf16_t*)(p.ws + WS_KC); bf16_t* vct = (bf16_t*)(p.ws + WS_VCT);
    const float* w2 = p.in[12] + (size_t)l * 2 * 128 * 64;
    for (int idx = gtid; idx < 4096 * 64; idx += gthreads) {
        const int r = idx >> 6, j = idx & 63, kvsel = r >> 11, bg = (r >> 8) & 7, c = r & 255;
        const float* w = w2 + (size_t)kvsel * 128 * 64 + j; const bf16_t* hr = hid + (size_t)r * 128;
        float s = 0.f;
#pragma unroll 8
        for (int k = 0; k < 128; ++k) s += bf2f(hr[k]) * w[k * 64];
        const unsigned short o = (unsigned short)(cvtpk(s, 0.f) & 0xffffu);
        if (kvsel == 0) kc[((size_t)bg * 256 + c) * 64 + j] = o; else vct[((size_t)bg * 64 + j) * 256 + c] = o;
    }
}
constexpr int CONV_SEG = 45;
DI void conv_phase(const Params& p, int l, int gtid, int gthreads) {
    const bf16_t* U = (const bf16_t*)(p.ws + WS_U); bf16_t* ACT = (bf16_t*)(p.ws + WS_ACT);
    const float* cw = p.in[17] + (size_t)l * 3 * 2 * DFF; const float* cb = p.in[18] + (size_t)l * 2 * DFF;
    constexpr int FV = DFF / 8, NSEG = (TC + CONV_SEG - 1) / CONV_SEG;
    for (int idx = gtid; idx < NSEG * FV; idx += gthreads) {
        const int seg = idx / FV, f0 = (idx % FV) * 8, t0 = seg * CONV_SEG, t1 = (t0 + CONV_SEG < TC) ? t0 + CONV_SEG : TC;
        float wa[3][8], wg[3][8], ba[8], bg[8];
#pragma unroll
        for (int k = 0; k < 3; ++k) {
            const f32x4 a0 = *(const f32x4*)(cw + (size_t)k * 2 * DFF + f0), a1 = *(const f32x4*)(cw + (size_t)k * 2 * DFF + f0 + 4);
            const f32x4 g0 = *(const f32x4*)(cw + (size_t)k * 2 * DFF + DFF + f0), g1 = *(const f32x4*)(cw + (size_t)k * 2 * DFF + DFF + f0 + 4);
            wa[k][0] = a0.x; wa[k][1] = a0.y; wa[k][2] = a0.z; wa[k][3] = a0.w; wa[k][4] = a1.x; wa[k][5] = a1.y; wa[k][6] = a1.z; wa[k][7] = a1.w;
            wg[k][0] = g0.x; wg[k][1] = g0.y; wg[k][2] = g0.z; wg[k][3] = g0.w; wg[k][4] = g1.x; wg[k][5] = g1.y; wg[k][6] = g1.z; wg[k][7] = g1.w;
        }
        { const f32x4 a0 = *(const f32x4*)(cb + f0), a1 = *(const f32x4*)(cb + f0 + 4), g0 = *(const f32x4*)(cb + DFF + f0), g1 = *(const f32x4*)(cb + DFF + f0 + 4);
          ba[0] = a0.x; ba[1] = a0.y; ba[2] = a0.z; ba[3] = a0.w; ba[4] = a1.x; ba[5] = a1.y; ba[6] = a1.z; ba[7] = a1.w;
          bg[0] = g0.x; bg[1] = g0.y; bg[2] = g0.z; bg[3] = g0.w; bg[4] = g1.x; bg[5] = g1.y; bg[6] = g1.z; bg[7] = g1.w; }
        u32x4 a2 = (u32x4){0u, 0u, 0u, 0u}, g2 = a2, a1 = a2, g1 = a2;
        if ((t0 & 4095) >= 2) { a2 = *(const u32x4*)(U + (size_t)(t0 - 2) * (2 * DFF) + f0); g2 = *(const u32x4*)(U + (size_t)(t0 - 2) * (2 * DFF) + DFF + f0); }
        if ((t0 & 4095) >= 1) { a1 = *(const u32x4*)(U + (size_t)(t0 - 1) * (2 * DFF) + f0); g1 = *(const u32x4*)(U + (size_t)(t0 - 1) * (2 * DFF) + DFF + f0); }
#define CONV_TOKEN(t_, a0_, g0_) do { \
            if (((t_) & 4095) == 0) { a2 = (u32x4){0u, 0u, 0u, 0u}; g2 = a2; a1 = a2; g1 = a2; }       \
            float o[8]; \
            CONV_E(0, LX, a0_, g0_) CONV_E(1, HX, a0_, g0_) CONV_E(2, LY, a0_, g0_) CONV_E(3, HY, a0_, g0_) CONV_E(4, LZ, a0_, g0_) CONV_E(5, HZ, a0_, g0_) CONV_E(6, LW, a0_, g0_) CONV_E(7, HW, a0_, g0_) \
            u32x4 w; w.x = cvtpk(o[0], o[1]); w.y = cvtpk(o[2], o[3]); w.z = cvtpk(o[4], o[5]); w.w = cvtpk(o[6], o[7]); \
            *(u32x4*)(ACT + (size_t)(t_) * DFF + f0) = w; \
            a2 = a1; g2 = g1; a1 = a0_; g1 = g0_; } while (0)
#define CONV_E(j_, W_, a0_, g0_) { const float av = ba[j_] + wa[0][j_] * W_(a2) + wa[1][j_] * W_(a1) + wa[2][j_] * W_(a0_); \
                                   const float gv = bg[j_] + wg[0][j_] * W_(g2) + wg[1][j_] * W_(g1) + wg[2][j_] * W_(g0_); o[j_] = av * sigmoidf_(av) * gv; }
#define LX(v) bflo((v).x)
#define HX(v) bfhi((v).x)
#define LY(v) bflo((v).y)
#define HY(v) bfhi((v).y)
#define LZ(v) bflo((v).z)
#define HZ(v) bfhi((v).z)
#define LW(v) bflo((v).w)
#define HW(v) bfhi((v).w)
        int t = t0;
        for (; t + 5 <= t1; t += 5) {
            u32x4 xa[5], xg[5];
#pragma unroll
            for (int k = 0; k < 5; ++k) { xa[k] = *(const u32x4*)(U + (size_t)(t + k) * (2 * DFF) + f0); xg[k] = *(const u32x4*)(U + (size_t)(t + k) * (2 * DFF) + DFF + f0); }
            CONV_TOKEN(t, xa[0], xg[0]); CONV_TOKEN(t + 1, xa[1], xg[1]); CONV_TOKEN(t + 2, xa[2], xg[2]); CONV_TOKEN(t + 3, xa[3], xg[3]); CONV_TOKEN(t + 4, xa[4], xg[4]);
        }
        for (; t < t1; ++t) {
            const u32x4 xa0 = *(const u32x4*)(U + (size_t)t * (2 * DFF) + f0), xg0 = *(const u32x4*)(U + (size_t)t * (2 * DFF) + DFF + f0);
            CONV_TOKEN(t, xa0, xg0);
        }
#undef CONV_TOKEN
#undef CONV_E
#undef LX
#undef HX
#undef LY
#undef HY
#undef LZ
#undef HZ
#undef LW
#undef HW
    }
}

namespace att {
constexpr int VRS = 144;
constexpr float NEGM = -1e30f, MFLOOR = -1e20f;
#define MFMA32(a, b, c) __builtin_amdgcn_mfma_f32_32x32x16_bf16((a), (b), (c), 0, 0, 0)
DI int crow(int i, int h) { return (i & 3) + 8 * (i >> 2) + 4 * h; }
template <int W1, int W2, int DV>
DI void dma_tile(LAS unsigned char* stage, const bf16_t* K1, int ldk1, const bf16_t* K2, int ldk2, const bf16_t* VT, int ldvt, int k0, int tid, int wave) {
    constexpr int DQK = W1 + W2, CPR = DQK / 8, KSZ = 64 * DQK * 2, KEYM = (DQK == 128) ? 15 : 7;
    const char* k1b = (const char*)(K1 + (size_t)k0 * ldk1); const char* k2b = (W2 != 0) ? (const char*)(K2 + (size_t)k0 * ldk2) : k1b; const char* vb = (const char*)(VT + k0);
#pragma unroll
    for (int i = 0; i < DQK / 64; ++i) { const int id = tid + 512 * i, pos = id / CPR, slot = id % CPR, row = pos ^ ((pos >> 3) & 1), ch = slot ^ (row & KEYM);
        const bool seg1 = (W2 == 0 || ch * 8 < W1);
        const unsigned off = seg1 ? (unsigned)(row * ldk1 + ch * 8) * 2u : (unsigned)(row * ldk2 + (ch * 8 - W1)) * 2u;
        __builtin_amdgcn_global_load_lds((const unsigned*)((seg1 ? k1b : k2b) + off), (LAS unsigned*)(stage + (wave * 64 + 512 * i) * 16), 16, 0, 0); }
#pragma unroll
    for (int i = 0; i < DV / 64; ++i) { const int id = tid + 512 * i, pos = id >> 3, slot = id & 7, d = pos ^ ((pos >> 3) & 1), ch = slot ^ (d & 7);
        const unsigned off = (unsigned)(d * ldvt + ch * 8) * 2u;
        __builtin_amdgcn_global_load_lds((const unsigned*)(vb + off), (LAS unsigned*)(stage + KSZ + (wave * 64 + 512 * i) * 16), 16, 0, 0); }
}
template <int DQK>
DI void qk_tile(f32x16& s0, f32x16& s1, const LAS unsigned char* Kb, const bf16x8 (&qf)[DQK / 16], int r, int h) {
    constexpr int ND = DQK / 16;
    const int rp = r ^ ((r >> 3) & 1), r7 = r & 7, rb = (r >> 3) & 1;
    const LAS unsigned char* kp = Kb + rp * (DQK * 2);
    const LAS unsigned char* kb4[4]; const LAS unsigned char* kb4x[4];
#pragma unroll
    for (int i = 0; i < 4; ++i) { kb4[i] = kp + (((2 * i + h) ^ r7) << 4) + ((DQK == 128) ? rb * 128 : 0); kb4x[i] = kp + (((2 * i + h) ^ r7) << 4) + ((DQK == 128) ? (1 - rb) * 128 : 128); }
    bf16x8 f[3][2];
#define QK_ADDR(d_) ((DQK == 128) ? ((((d_) >> 2) & 1) ? kb4x[(d_) & 3] : kb4[(d_) & 3]) : (kb4[(d_) & 3] + ((d_) >> 2) * 128))
#define QK_LOAD(d_, buf_) do { f[buf_][0] = *(const LAS bf16x8*)(QK_ADDR(d_)); f[buf_][1] = *(const LAS bf16x8*)(QK_ADDR(d_) + 32 * DQK * 2); } while (0)
    QK_LOAD(0, 0); QK_LOAD(1, 1);
#pragma unroll
    for (int d0 = 0; d0 < ND; ++d0) {
        if (d0 + 2 < ND) QK_LOAD(d0 + 2, (d0 + 2) % 3);
        __builtin_amdgcn_sched_barrier(0);
        s0 = MFMA32(f[d0 % 3][0], qf[d0], s0); s1 = MFMA32(f[d0 % 3][1], qf[d0], s1);
    }
#undef QK_LOAD
#undef QK_ADDR
}
constexpr float THR = 8.f;
DI float hmax32(float v) { auto rr = __builtin_amdgcn_permlane32_swap(__float_as_uint(v), __float_as_uint(v), false, false); return fmaxf(__uint_as_float(rr[0]), __uint_as_float(rr[1])); }
DI bool softmax_step(f32x16& x0, f32x16& x1, float toff, float& m, float& l, float& alpha) {
    float mx = __builtin_fmaxf(x0[0], x1[0]);
#pragma unroll
    for (int i = 1; i < 16; ++i) mx = __builtin_fmaxf(__builtin_fmaxf(mx, x0[i]), x1[i]);
    const float mt = hmax32(mx) + toff;
    const bool need = mt > m + THR;
    const float mn = need ? mt : m;
    alpha = __builtin_amdgcn_exp2f(m - mn); m = mn;
    const float sub = mn - toff;
    f32x2_t s2 = {0.f, 0.f};
#pragma unroll
    for (int i = 0; i < 16; ++i) { x0[i] = __builtin_amdgcn_exp2f(x0[i] - sub); x1[i] = __builtin_amdgcn_exp2f(x1[i] - sub); }
#pragma unroll
    for (int i = 0; i < 16; i += 2) { s2 += (f32x2_t){x0[i], x0[i + 1]}; s2 += (f32x2_t){x1[i], x1[i + 1]}; }
    const float s = s2.x + s2.y;
    const bool any = __any(need) != 0;
    l = (any ? l * alpha : l) + s;
    return any;
}
DI bf16x8 pack8(const f32x16& x, int s) {
    u32x4 w; w.x = cvtpk(x[8 * s], x[8 * s + 1]); w.y = cvtpk(x[8 * s + 2], x[8 * s + 3]); w.z = cvtpk(x[8 * s + 4], x[8 * s + 5]); w.w = cvtpk(x[8 * s + 6], x[8 * s + 7]);
    return __builtin_bit_cast(bf16x8, w);
}
DI void pack_p(bf16x8 (&pk)[4], const f32x16& p0, const f32x16& p1) { pk[0] = pack8(p0, 0); pk[1] = pack8(p0, 1); pk[2] = pack8(p1, 0); pk[3] = pack8(p1, 1); }
template <int DV>
DI void pv_tile(f32x16 (&o)[DV / 32], const LAS unsigned char* Vb, const bf16x8 (&pk)[4], int r, int h) {
    constexpr int NS = DV / 16;
    const int r7 = r & 7;
    const LAS unsigned char* vp = Vb + (r ^ ((r >> 3) & 1)) * 128 + h * 8;
    const LAS unsigned char* vb8[8];
#pragma unroll
    for (int i = 0; i < 8; ++i) vb8[i] = vp + ((i ^ r7) << 4);
    s16x4 lo[3][2], hi[3][2];
#define PV_LOAD(s_, buf_) do { _Pragma("unroll") for (int jj = 0; jj < 2; ++jj) { const int j_ = 2 * ((s_) & 1) + jj; \
        lo[buf_][jj] = *(const LAS s16x4*)(vb8[2 * j_] + ((s_) >> 1) * 4096); hi[buf_][jj] = *(const LAS s16x4*)(vb8[2 * j_ + 1] + ((s_) >> 1) * 4096); } } while (0)
    PV_LOAD(0, 0); PV_LOAD(1, 1);
#pragma unroll
    for (int s = 0; s < NS; ++s) {
        if (s + 2 < NS) PV_LOAD(s + 2, (s + 2) % 3);
        __builtin_amdgcn_sched_barrier(0);
#pragma unroll
        for (int jj = 0; jj < 2; ++jj) {
            const bf16x8 vf = __builtin_shufflevector(lo[s % 3][jj], hi[s % 3][jj], 0, 1, 2, 3, 4, 5, 6, 7);
            o[s >> 1] = MFMA32(vf, pk[2 * (s & 1) + jj], o[s >> 1]);
        }
    }
#undef PV_LOAD
}
template <int NQ>
DI void load_q(bf16x8 (&qf)[NQ], const bf16_t* qrow, int h) {
#pragma unroll
    for (int d0 = 0; d0 < NQ; ++d0) qf[d0] = *(const bf16x8*)(qrow + d0 * 16 + h * 8);
}
}

#define ATT_WAITV(n_) asm volatile("s_waitcnt vmcnt(%0)" :: "n"(n_) : "memory")
#define ATT_LOOP_BEGIN(nt_, K0_, W1_, W2_, DV_, K1p_, ldk1_, K2p_, ldk2_, VTp_, ldvt_, XF_, CUMP_, NST_, DIST_) \
  { constexpr int KSZ_ = 64 * ((W1_) + (W2_)) * 2, SSZ_ = KSZ_ + (DV_) * 128, NL_ = ((W1_) + (W2_)) / 64 + (DV_) / 64 + ((XF_) ? 1 : 0), NSTG_ = (NST_); const int nt__ = (nt_); \
    _Pragma("unroll") for (int pt_ = 0; pt_ < (DIST_); ++pt_) { if (pt_ < nt__) { const int t = pt_; att::dma_tile<W1_, W2_, DV_>(Ks + pt_ * SSZ_, K1p_, ldk1_, K2p_, ldk2_, VTp_, ldvt_, (K0_), tid, wave); \
      if (XF_) { if (lane < 16) __builtin_amdgcn_global_load_lds((const unsigned*)((CUMP_) + (K0_) + lane * 4), (LAS unsigned*)(Cw + pt_ * 2048), 16, 0, 0); } } } \
    int sp_ = NSTG_ - 1, sc_ = 0, sn_ = (DIST_); \
    for (int t_ = 0; t_ < nt__; ++t_) { \
      if ((DIST_) == 2 && t_ + 1 < nt__) ATT_WAITV(NL_); else ATT_WAITV(0); \
      __builtin_amdgcn_s_barrier(); asm volatile("" ::: "memory"); \
      if (t_ + (DIST_) < nt__) { const int t = t_ + (DIST_); att::dma_tile<W1_, W2_, DV_>(Ks + sn_ * SSZ_, K1p_, ldk1_, K2p_, ldk2_, VTp_, ldvt_, (K0_), tid, wave); \
        if (XF_) { if (lane < 16) __builtin_amdgcn_global_load_lds((const unsigned*)((CUMP_) + (K0_) + lane * 4), (LAS unsigned*)(Cw + sn_ * 2048), 16, 0, 0); } } \
      { const int t = t_; const int k0 = (K0_); const bool lastt = (t_ + 1 == nt__); const LAS unsigned char* Kb = Ks + sc_ * SSZ_; const LAS unsigned char* Vb = Kb + KSZ_; const LAS unsigned char* Vprev = Ks + sp_ * SSZ_ + KSZ_; \
        const LAS float* Cb = (const LAS float*)(Cw + sc_ * 2048); (void)k0; (void)Kb; (void)Vb; (void)Cb; (void)Vprev; (void)lastt;
#define ATT_LOOP_END() \
      } \
      sp_ = sc_; sc_ = (sc_ == NSTG_ - 1) ? 0 : sc_ + 1; sn_ = (sn_ == NSTG_ - 1) ? 0 : sn_ + 1; } \
    asm volatile("s_waitcnt lgkmcnt(0)" ::: "memory"); __builtin_amdgcn_s_barrier(); asm volatile("" ::: "memory"); }

template <int TYPE>
DI void abc_unit(const Params& p, int l, int bloc, int hd, int qb, LAS unsigned char* lds, int tid, bool dummy) {
    asm volatile("" : "+v"(tid));
    constexpr int W1 = (TYPE == 0) ? 64 : 128, W2 = (TYPE == 1) ? 64 : 0, DQK = W1 + W2, DV = 128, NQ = DQK / 16;
    constexpr int RING = 3 * (64 * DQK * 2 + DV * 128);
    LAS unsigned char* Ks = lds;
    const int lane = tid & 63, wave = __builtin_amdgcn_readfirstlane(tid >> 6), r = lane & 31, h = lane >> 5;
    const int q0 = qb * 256, qw0 = q0 + 32 * wave, qpos = qw0 + r, tb = bloc * SEQ;
    bf16_t* PRM = (bf16_t*)(p.ws + WS_PRM);
    const bf16_t* VTall = (const bf16_t*)(p.ws + WS_VT);
    const float* ctlf = (const float*)(p.ws + WS_CTL);
    const int NT = 4 * (qb + 1);
    const float sl2 = __builtin_amdgcn_exp2f(-2.f * (float)(hd + 1)) * LOG2E;
    float cq2 = 0.f; const float* cum = nullptr;
    if (TYPE == 2) { cum = (const float*)(p.ws + WS_CUM) + (size_t)(bloc * 4 + hd) * SEQ; cq2 = -cum[qpos]; }
    const float sl2h = sl2 * (float)(4 * h);
    LAS unsigned char* Cw = lds + RING + wave * 256;
    LAS unsigned* park = (LAS unsigned*)(lds + RING) + wave * 2048 + lane;
    f32x16 o[4];
    float m, lsum;
    bf16x8 pk[4];
    const bool lagw = wave >= 4;
#pragma nounroll
    for (int pass = 0; pass < ((TYPE == 0) ? 2 : 1); ++pass) {
        const bf16_t *Qp, *K1p, *K2p = nullptr, *VTp; int ldq, ldk1, ldk2 = 0;
        if (TYPE == 0) { Qp = PRM + C_AQ + hd * 128 + pass * 64; ldq = LDP; K1p = PRM + (size_t)tb * LDP + C_AK + hd * 128 + pass * 64; ldk1 = LDP; VTp = VTall + (size_t)(R_AV + hd * 128) * LDVT + tb; }
        else if (TYPE == 1) { Qp = (const bf16_t*)(p.ws + WS_QF) + hd * 192; ldq = 768; K1p = (const bf16_t*)(p.ws + WS_KN) + (size_t)tb * 512 + hd * 128; ldk1 = 512;
                              K2p = PRM + (size_t)tb * LDP + C_KR; ldk2 = LDP; VTp = (const bf16_t*)(p.ws + WS_MVT) + (size_t)(hd * 128) * LDVT + tb; }
        else { Qp = PRM + C_CQ + hd * 128; ldq = LDP; K1p = PRM + (size_t)tb * LDP + C_CK + hd * 128; ldk1 = LDP; VTp = VTall + (size_t)(R_CV + hd * 128) * LDVT + tb; }
        bf16x8 qf[NQ];
        att::load_q<NQ>(qf, Qp + (size_t)(tb + qpos) * ldq, h);
        m = att::MFLOOR; lsum = 0.f;
#pragma unroll
        for (int db = 0; db < 4; ++db)
#pragma unroll
            for (int i = 0; i < 16; ++i) o[db][i] = 0.f;
        bool havep = false;
        ATT_LOOP_BEGIN(NT, (NT - 1 - t) * 64, W1, W2, DV, K1p, ldk1, K2p, ldk2, VTp, LDVT, (TYPE == 2), cum, 3, 1)
            if (lagw && havep) att::pv_tile<DV>(o, Vprev, pk, r, h);
            if (k0 <= qw0 + 31) {
                f32x16 s0, s1; float toff;
                if (TYPE == 0) {
#pragma unroll
                    for (int i = 0; i < 16; ++i) { s0[i] = __builtin_fmaf(sl2, (float)((i & 3) + 8 * (i >> 2)), sl2h); s1[i] = s0[i] + sl2 * 32.f; }
                    toff = sl2 * (float)(k0 - qpos);
                } else if (TYPE == 2) {
#pragma unroll
                    for (int k = 0; k < 4; ++k) { const f32x4 c0 = *(const LAS f32x4*)(Cb + 8 * k + 4 * h), c1 = *(const LAS f32x4*)(Cb + 32 + 8 * k + 4 * h);
                        s0[4 * k] = c0.x; s0[4 * k + 1] = c0.y; s0[4 * k + 2] = c0.z; s0[4 * k + 3] = c0.w; s1[4 * k] = c1.x; s1[4 * k + 1] = c1.y; s1[4 * k + 2] = c1.z; s1[4 * k + 3] = c1.w; }
                    toff = cq2;
                } else {
#pragma unroll
                    for (int i = 0; i < 16; ++i) { s0[i] = 0.f; s1[i] = 0.f; }
                    toff = 0.f;
                }
                att::qk_tile<DQK>(s0, s1, Kb, qf, r, h);
                if (k0 + 63 > qw0) {
                    asm volatile("" ::: "memory");
#pragma unroll
                    for (int i = 0; i < 16; ++i) { const int kv = k0 + att::crow(i, h); if (kv > qpos) s0[i] = att::NEGM; if (kv + 32 > qpos) s1[i] = att::NEGM; }
                }
                float alpha;
                if (att::softmax_step(s0, s1, toff, m, lsum, alpha)) {
#pragma unroll
                    for (int db = 0; db < 4; ++db)
#pragma unroll
                        for (int i = 0; i < 16; ++i) o[db][i] *= alpha;
                }
                att::pack_p(pk, s0, s1);
                if (!lagw || lastt) att::pv_tile<DV>(o, Vb, pk, r, h); else havep = true;
            }
        ATT_LOOP_END()
        const float lt = hsum32(lsum);
        const float inv = lt > 0.f ? 1.f / lt : 0.f;
        if (TYPE == 0 && pass == 0) {
#pragma unroll
            for (int db = 0; db < 4; ++db)
#pragma unroll
                for (int i = 0; i < 8; ++i) park[(db * 8 + i) * 64] = cvtpk(o[db][2 * i] * inv, o[db][2 * i + 1] * inv);
        } else {
#pragma unroll
            for (int db = 0; db < 4; ++db)
#pragma unroll
                for (int i = 0; i < 16; ++i) o[db][i] *= inv;
        }
    }
    int qp2 = qpos; asm volatile("" : "+v"(qp2)); qp2 += tb;
    bf16_t* Yp = PRM + (size_t)qp2 * LDP + ((TYPE == 0) ? C_AQ : (TYPE == 1) ? C_YB : C_CQ) + hd * 128;
    if (dummy) Yp = (bf16_t*)(p.ws + WS_MRG) + (size_t)qp2 * 1024 + hd * 128;
    if (TYPE == 0) {
        const float lam = ctlf[CF_LAM], lam_init = ctlf[CF_LAM + 1];
        const float* sub = p.in[4] + (size_t)l * 128;
        float ss = 0.f;
#pragma unroll
        for (int db = 0; db < 4; ++db)
#pragma unroll
            for (int i = 0; i < 8; ++i) { const unsigned pw = park[(db * 8 + i) * 64]; const float a = bflo(pw) - lam * o[db][2 * i], b = bfhi(pw) - lam * o[db][2 * i + 1]; o[db][2 * i] = a; o[db][2 * i + 1] = b; ss += a * a + b * b; }
        ss = hsum32(ss);
        const float rs = (1.f - lam_init) / sqrtf(ss * (1.f / 128.f) + EPS);
#pragma unroll
        for (int db = 0; db < 4; ++db)
#pragma unroll
            for (int k = 0; k < 4; ++k) { const int d = 32 * db + 8 * k + 4 * h; const f32x4 gg = *(const f32x4*)(sub + d);
                o[db][4 * k] *= rs * gg.x; o[db][4 * k + 1] *= rs * gg.y; o[db][4 * k + 2] *= rs * gg.z; o[db][4 * k + 3] *= rs * gg.w; }
    }
#pragma unroll
    for (int db = 0; db < 4; ++db)
#pragma unroll
        for (int k = 0; k < 4; ++k) { u32x2 w; w.x = cvtpk(o[db][4 * k], o[db][4 * k + 1]); w.y = cvtpk(o[db][4 * k + 2], o[db][4 * k + 3]); *(u32x2*)(Yp + 32 * db + 8 * k + 4 * h) = w; }
}

DI void nsa_unit(const Params& p, int l, int bloc, int g, int qblk, LAS unsigned char* lds, int tid, bool dummy) {
    asm volatile("" : "+v"(tid));
    LAS unsigned char* Ks = lds; LAS unsigned char* Cw = lds;
    LAS float* IMP = (LAS float*)(lds + 65536);
    LAS unsigned* SELM = (LAS unsigned*)(lds + 65536 + 66560);
    LAS int* SELT = (LAS int*)(lds + 65536 + 66560 + 512);
    const int lane = tid & 63, wave = __builtin_amdgcn_readfirstlane(tid >> 6), r = lane & 31, h = lane >> 5;
    const int hg = wave >> 1, qrow = 32 * (wave & 1) + r, q0 = qblk * 64, qpos = q0 + qrow, blk = qblk, hh = g * 4 + hg, tb = bloc * SEQ;
    bf16_t* PRM = (bf16_t*)(p.ws + WS_PRM);
    const bf16_t* VTall = (const bf16_t*)(p.ws + WS_VT);
    const float sl2 = __builtin_amdgcn_exp2f(-(float)(hh + 1)) * LOG2E;
    bf16_t* qrowp = PRM + (size_t)(tb + qpos) * LDP;
    bf16x8 qf[4]; att::load_q<4>(qf, qrowp + C_DQ + hh * 64, h);
    const float gt0 = bf2f(qrowp[C_DG + hh * 3]), gt1 = bf2f(qrowp[C_DG + hh * 3 + 1]), gt2 = bf2f(qrowp[C_DG + hh * 3 + 2]);
    for (int i = tid; i < 4 * 64 * 65; i += 512) IMP[i] = 0.f;
    f32x16 tot[2], o[2];
    float m, ls;
    bf16x8 pk[4];
    const bool lagw = wave >= 4;
    const bf16_t* KCp = (const bf16_t*)(p.ws + WS_KC) + (size_t)(bloc * 2 + g) * 256 * 64;
    const bf16_t* VCp = (const bf16_t*)(p.ws + WS_VCT) + (size_t)(bloc * 2 + g) * 64 * 256;
    const int ntc = ((q0 + 32) >> 10) + 1;
    const float sl2h = sl2 * (float)(4 * h);
#define PAT(i) __builtin_fmaf(sl2, (float)(((i) & 3) + 8 * ((i) >> 2)), sl2h)
#define CMP_SCORES() \
        f32x16 s0, s1; \
        _Pragma("unroll") for (int i = 0; i < 16; ++i) { s0[i] = 16.f * PAT(i); s1[i] = s0[i] + sl2 * 512.f; } \
        const float toff = sl2 * (float)(16 * k0 + 31 - qpos); \
        att::qk_tile<64>(s0, s1, Kb, qf, r, h); \
        _Pragma("unroll") for (int i = 0; i < 16; ++i) { const int d0 = qpos - 31 - 16 * (k0 + att::crow(i, h)); if (d0 < 0) s0[i] = att::NEGM; if (d0 < 512) s1[i] = att::NEGM; }
    m = att::MFLOOR; ls = 0.f;
    ATT_LOOP_BEGIN(ntc, (ntc - 1 - t) * 64, 64, 0, 64, KCp, 64, (const bf16_t*)nullptr, 0, VCp, 256, false, (const float*)nullptr, 4, 2)
        CMP_SCORES();
        float alpha; (void)att::softmax_step(s0, s1, toff, m, ls, alpha);
    ATT_LOOP_END()
    {
        const float lt = hsum32(ls); const float inv = lt > 0.f ? 1.f / lt : 0.f;
#pragma unroll
        for (int db = 0; db < 2; ++db)
#pragma unroll
            for (int i = 0; i < 16; ++i) o[db][i] = 0.f;
        LAS float* improw = IMP + (hg * 64 + qrow) * 65;
        ATT_LOOP_BEGIN(ntc, (ntc - 1 - t) * 64, 64, 0, 64, KCp, 64, (const bf16_t*)nullptr, 0, VCp, 256, false, (const float*)nullptr, 4, 2)
            CMP_SCORES();
            const float sub = m - toff;
#pragma unroll
            for (int i = 0; i < 16; ++i) { s0[i] = __builtin_amdgcn_exp2f(s0[i] - sub) * inv; s1[i] = __builtin_amdgcn_exp2f(s1[i] - sub) * inv; }
#pragma unroll
            for (int k = 0; k < 4; ++k) {
                const int j = (k0 >> 2) + 2 * k + h;
                const float sp0 = 0.5f * s0[4 * k + 3], sp1 = 0.5f * s1[4 * k + 3];
                __hip_atomic_fetch_add(improw + j, (s0[4 * k] + s0[4 * k + 1]) + (s0[4 * k + 2] + sp0), __ATOMIC_RELAXED, __HIP_MEMORY_SCOPE_WORKGROUP);
                __hip_atomic_fetch_add(improw + j + 1, sp0, __ATOMIC_RELAXED, __HIP_MEMORY_SCOPE_WORKGROUP);
                __hip_atomic_fetch_add(improw + j + 8, (s1[4 * k] + s1[4 * k + 1]) + (s1[4 * k + 2] + sp1), __ATOMIC_RELAXED, __HIP_MEMORY_SCOPE_WORKGROUP);
                __hip_atomic_fetch_add(improw + j + 9, sp1, __ATOMIC_RELAXED, __HIP_MEMORY_SCOPE_WORKGROUP);
            }
            att::pack_p(pk, s0, s1); att::pv_tile<64>(o, Vb, pk, r, h);
        ATT_LOOP_END()
#pragma unroll
        for (int db = 0; db < 2; ++db)
#pragma unroll
            for (int i = 0; i < 16; ++i) tot[db][i] = gt0 * o[db][i];
    }
    for (int rr = 0; rr < 8; ++rr) {
        const int q = wave * 8 + rr, j = lane;
        float v = ((IMP[(0 * 64 + q) * 65 + j] + IMP[(1 * 64 + q) * 65 + j]) + IMP[(2 * 64 + q) * 65 + j]) + IMP[(3 * 64 + q) * 65 + j];
        const bool forced = (j == 0) | (j == blk) | (j == blk - 1);
        v = (j > blk) ? -3.0e38f : (forced ? 1.0e9f : v);
        int cnt = 0;
#pragma unroll 4
        for (int i = 0; i < 64; ++i) { const float vi = __uint_as_float((unsigned)__builtin_amdgcn_readlane((int)__float_as_uint(v), i)); cnt += ((vi > v) || (vi == v && i < j)) ? 1 : 0; }
        const unsigned long long mask = __ballot((cnt < 8) && (j <= blk));
        if (lane == 0) { SELM[2 * q] = (unsigned)mask; SELM[2 * q + 1] = (unsigned)(mask >> 32); }
    }
    __syncthreads();
    unsigned ulo = SELM[2 * lane], uhi = SELM[2 * lane + 1];
    ulo = wave_or(ulo); uhi = wave_or(uhi);
    const int nts = __builtin_amdgcn_readfirstlane(__popc(ulo) + __popc(uhi));
    if (tid < 64) { const unsigned long long un = ((unsigned long long)uhi << 32) | ulo;
        if ((un >> tid) & 1ull) SELT[__popcll(un & ((1ull << tid) - 1ull))] = tid; }
    const unsigned mylo = SELM[2 * qrow], myhi = SELM[2 * qrow + 1];
    __syncthreads();
    LAS float* tpark = IMP + wave * 2048 + lane;
#pragma unroll
    for (int db = 0; db < 2; ++db)
#pragma unroll
        for (int i = 0; i < 16; ++i) tpark[(db * 16 + i) * 64] = tot[db][i];
    {
        const bf16_t* K1p = PRM + (size_t)tb * LDP + C_DKS + g * 64; const bf16_t* VTp = VTall + (size_t)(R_DVS + g * 64) * LDVT + tb;
        m = att::MFLOOR; ls = 0.f;
#pragma unroll
        for (int db = 0; db < 2; ++db)
#pragma unroll
            for (int i = 0; i < 16; ++i) o[db][i] = 0.f;
        bool havep = false;
        ATT_LOOP_BEGIN(nts, SELT[nts - 1 - t] * 64, 64, 0, 64, K1p, LDP, (const bf16_t*)nullptr, 0, VTp, LDVT, false, (const float*)nullptr, 4, 2)
            if (lagw && havep) { att::pv_tile<64>(o, Vprev, pk, r, h); havep = false; }
            const int j = k0 >> 6; const bool lsel = ((j < 32 ? (mylo >> j) : (myhi >> (j - 32))) & 1u) != 0u;
            if (__any(lsel)) {
                f32x16 s0, s1;
#pragma unroll
                for (int i = 0; i < 16; ++i) { s0[i] = PAT(i); s1[i] = s0[i] + sl2 * 32.f; }
                const float toff = lsel ? sl2 * (float)(k0 - qpos) : att::NEGM;
                att::qk_tile<64>(s0, s1, Kb, qf, r, h);
                if (j == blk) {
                    asm volatile("" ::: "memory");
#pragma unroll
                    for (int i = 0; i < 16; ++i) { const int kv = k0 + att::crow(i, h); if (kv > qpos) s0[i] = att::NEGM; if (kv + 32 > qpos) s1[i] = att::NEGM; }
                }
                float alpha;
                if (att::softmax_step(s0, s1, toff, m, ls, alpha)) {
#pragma unroll
                    for (int db = 0; db < 2; ++db)
#pragma unroll
                        for (int i = 0; i < 16; ++i) o[db][i] *= alpha;
                }
                att::pack_p(pk, s0, s1);
                if (!lagw || lastt) att::pv_tile<64>(o, Vb, pk, r, h); else havep = true;
            }
        ATT_LOOP_END()
        const float lt = hsum32(ls); const float inv = (lt > 0.f ? 1.f / lt : 0.f) * gt1;
#pragma unroll
        for (int db = 0; db < 2; ++db)
#pragma unroll
            for (int i = 0; i < 16; ++i) tpark[(db * 16 + i) * 64] += inv * o[db][i];
    }
    {
        const bf16_t* K1p = PRM + (size_t)tb * LDP + C_DKW + g * 64; const bf16_t* VTp = VTall + (size_t)(R_DVW + g * 64) * LDVT + tb;
        const int t0 = blk > 4 ? blk - 4 : 0, ntw = blk - t0 + 1;
        m = att::MFLOOR; ls = 0.f;
#pragma unroll
        for (int db = 0; db < 2; ++db)
#pragma unroll
            for (int i = 0; i < 16; ++i) o[db][i] = 0.f;
        bool havep = false;
        ATT_LOOP_BEGIN(ntw, (blk - t) * 64, 64, 0, 64, K1p, LDP, (const bf16_t*)nullptr, 0, VTp, LDVT, false, (const float*)nullptr, 4, 2)
            if (lagw && havep) att::pv_tile<64>(o, Vprev, pk, r, h);
            f32x16 s0, s1;
#pragma unroll
            for (int i = 0; i < 16; ++i) { s0[i] = PAT(i); s1[i] = s0[i] + sl2 * 32.f; }
            const float toff = sl2 * (float)(k0 - qpos);
            att::qk_tile<64>(s0, s1, Kb, qf, r, h);
            if (t == 0 || t + 1 == ntw) {
                asm volatile("" ::: "memory");
#pragma unroll
                for (int i = 0; i < 16; ++i) { const int d0 = qpos - (k0 + att::crow(i, h)), d1 = d0 - 32;
                    if (d0 < 0 || d0 >= 256) s0[i] = att::NEGM; if (d1 < 0 || d1 >= 256) s1[i] = att::NEGM; }
            }
            float alpha;
            if (att::softmax_step(s0, s1, toff, m, ls, alpha)) {
#pragma unroll
                for (int db = 0; db < 2; ++db)
#pragma unroll
                    for (int i = 0; i < 16; ++i) o[db][i] *= alpha;
            }
            att::pack_p(pk, s0, s1);
            if (!lagw || lastt) att::pv_tile<64>(o, Vb, pk, r, h); else havep = true;
        ATT_LOOP_END()
        const float lt = hsum32(ls); const float inv = (lt > 0.f ? 1.f / lt : 0.f) * gt2;
#pragma unroll
        for (int db = 0; db < 2; ++db)
#pragma unroll
            for (int i = 0; i < 16; ++i) tot[db][i] = tpark[(db * 16 + i) * 64] + inv * o[db][i];
    }
    int qp2 = qpos; asm volatile("" : "+v"(qp2)); qp2 += tb;
    bf16_t* Yp = PRM + (size_t)qp2 * LDP + C_DQ + hh * 64;
    if (dummy) Yp = (bf16_t*)(p.ws + WS_MRG) + (size_t)qp2 * 1024 + hh * 64;
#pragma unroll
    for (int db = 0; db < 2; ++db)
#pragma unroll
        for (int k = 0; k < 4; ++k) { u32x2 w; w.x = cvtpk(tot[db][4 * k], tot[db][4 * k + 1]); w.y = cvtpk(tot[db][4 * k + 2], tot[db][4 * k + 3]); *(u32x2*)(Yp + 32 * db + 8 * k + 4 * h) = w; }
#undef CMP_SCORES
#undef PAT
}

#define XB_TMO      128
#define XB_XCNT(j)  (256  + 64 * (j))
#define XB_XSUB(j)  (1280 + 64 * (j))
#define XB_XGEN(j)  (2304 + 64 * (j))
#define XB_TOP      3328
#define XB_TOPGEN   3392
#define XCD_BAR_WORDS 3456
#define XB_SPIN_CAP (1u << 20)
DI unsigned xb_ld(unsigned* p)              { return __hip_atomic_load(p, __ATOMIC_RELAXED, __HIP_MEMORY_SCOPE_AGENT); }
DI unsigned xb_add(unsigned* p, unsigned v) { return __hip_atomic_fetch_add(p, v, __ATOMIC_RELAXED, __HIP_MEMORY_SCOPE_AGENT); }
DI unsigned xb_xcc_id() { return (unsigned)__builtin_amdgcn_s_getreg((3 << 11) | 20) & 0xFu; }
#define XB_SPIN(cond, bar) do { unsigned _sp = 0; while (cond) { __builtin_amdgcn_s_sleep(1); \
    if ((++_sp & 255u) == 0u) { if (xb_ld(&(bar)[XB_TMO])) break; if (_sp > XB_SPIN_CAP) { atomicAdd(&(bar)[XB_TMO], 1u); break; } } } } while (0)
struct XcdBarrier { unsigned* bar; unsigned x; volatile LAS unsigned* st; };
DI XcdBarrier xcd_barrier_post(unsigned* bar, volatile LAS unsigned* st) {
    XcdBarrier b; b.bar = bar; b.x = xb_xcc_id(); b.st = st;
    if (threadIdx.x == 0) (void)xb_add(&bar[XB_XCNT(b.x)], 1u);
    return b;
}
DI void xcd_barrier_complete(unsigned* bar, unsigned x, unsigned& nloc, unsigned& nx) {
    const unsigned G = gridDim.x * gridDim.y * gridDim.z;
    unsigned sum, cnt, mine, sp = 0u;
    for (;;) {
        sum = 0u; cnt = 0u; mine = 0u;
#pragma unroll
        for (unsigned j = 0; j < 16; ++j) { const unsigned c = xb_ld(&bar[XB_XCNT(j)]); sum += c; cnt += (c > 0u) ? 1u : 0u; mine = (j == x) ? c : mine; }
        if (sum == G) break;
        __builtin_amdgcn_s_sleep(1);
        if ((++sp & 255u) == 0u) { if (xb_ld(&bar[XB_TMO])) break; if (sp > XB_SPIN_CAP) { atomicAdd(&bar[XB_TMO], 1u); break; } }
    }
    nloc = mine > 0u ? mine : 1u; nx = cnt > 0u ? cnt : 1u;
}
DI void xcd_barrier(const XcdBarrier& b, int tid) {
    asm volatile("s_waitcnt vmcnt(0)" ::: "memory");
    __syncthreads();
    if (tid == 0) {
        unsigned* bar = b.bar;
        __builtin_amdgcn_s_waitcnt(0);
        unsigned nloc = b.st[0], nx = b.st[1];
        if (nloc == 0u) { xcd_barrier_complete(bar, b.x, nloc, nx); b.st[0] = nloc; b.st[1] = nx; }
        const unsigned old = xb_add(&bar[XB_XSUB(b.x)], 1u);
        const unsigned gen = old / nloc;
        if (old + 1u == (gen + 1u) * nloc) {
            __builtin_amdgcn_fence(__ATOMIC_RELEASE, "agent");
            asm volatile("s_waitcnt vmcnt(0)" ::: "memory");
            const unsigned og = xb_add(&bar[XB_TOP], 1u);
            const unsigned tg = og / nx;
            if (og + 1u == (tg + 1u) * nx) xb_add(&bar[XB_TOPGEN], 1u);
            else XB_SPIN(xb_ld(&bar[XB_TOPGEN]) == tg, bar);
            __builtin_amdgcn_fence(__ATOMIC_ACQUIRE, "agent");
            xb_add(&bar[XB_XGEN(b.x)], 1u);
            asm volatile("s_waitcnt vmcnt(0)" ::: "memory");
        } else {
            XB_SPIN(xb_ld(&bar[XB_XGEN(b.x)]) == gen, bar);
            __builtin_amdgcn_fence(__ATOMIC_ACQUIRE, "agent");
            asm volatile("s_waitcnt vmcnt(0)" ::: "memory");
        }
    }
    __syncthreads();
}

constexpr int N_UNITS = 1280, CW_ORDER = 8192;
DI float unit_cost(int u) {
    if (u < 768) { const int qb = u / 48, type = (u % 48) >> 4; return (float)(qb + 1) * (type == 0 ? 10.7f : 8.7f); }
    const int i2 = u - 768, qblk = i2 >> 3, g = i2 & 1; return 1000.f + (float)qblk + 0.5f * (float)g;
}
constexpr int LDS_BYTES = 147456, LDS_MISC = LDS_BYTES - 512;
__global__ void __launch_bounds__(512, 2) mega_fwd(Params p) {
    extern __shared__ __attribute__((aligned(16))) unsigned char smem[];
    LAS unsigned char* lds = (LAS unsigned char*)smem;
    cg::grid_group grid = cg::this_grid();
    const int G = gridDim.x, bid = blockIdx.x, ngw = G * 8, gthreads = G * 512;
    const int wave0 = __builtin_amdgcn_readfirstlane((int)(threadIdx.x >> 6));
    { volatile LAS unsigned* bst0 = (volatile LAS unsigned*)(lds + LDS_MISC + 64); if (threadIdx.x == 0) { bst0[0] = 0u; bst0[1] = 0u; } }
    __syncthreads();
    volatile LAS unsigned* bst = (volatile LAS unsigned*)(lds + LDS_MISC + 64);
    (void)xcd_barrier_post((unsigned*)(p.ws + WS_CTL) + CW_BAR, bst);
    for (int l = 0; l < 2; ++l) {
        for (int c = 0; c < NCHUNK; ++c) {
#ifndef PROBE_S
#define PROBE_S -1
#endif
            for (int s_ = 0; s_ < ((PROBE_S >= 0) ? 20 : 19); ++s_) {
                const int s = (s_ == 19) ? PROBE_S : (s_ < 2) ? s_ : (s_ == 2) ? 18 : (s_ < 8) ? s_ - 1 : (s_ == 8) ? 17 : s_ - 2;
                unsigned char* ws = p.ws; asm volatile("" : "+s"(ws));
                unsigned* ctl = (unsigned*)(ws + WS_CTL); float* ctlf = (float*)ctl;
                bf16_t* H = (bf16_t*)(ws + WS_H); bf16_t* PRM = (bf16_t*)(ws + WS_PRM); bf16_t* GATES = (bf16_t*)(ws + WS_GATES);
                bf16_t* WIN = (bf16_t*)(ws + WS_WIN); bf16_t* WUKV = (bf16_t*)(ws + WS_WUKV); bf16_t* MRG = (bf16_t*)(ws + WS_MRG);
                const size_t tok0 = (size_t)c * TC;
                const float* xin = (l == 0) ? p.in[0] : p.out;
                bool isg = false;
                pg8::Gemm g{nullptr, nullptr, 0, 0, 0, 0, 0};
                pg8::Epi E{pg8::M_PLAIN, 0, nullptr, 0, nullptr, nullptr, nullptr, nullptr};
                switch (s) {
                case 1: g = pg8::Gemm{H, WIN, TC, C_GATE, DM, DM, DM}; E.mode = pg8::M_INRM; E.o0 = PRM; E.o1 = GATES; E.o2 = (bf16_t*)(ws + WS_CKV); E.f0 = (float*)(ws + WS_LOGF); E.f1 = p.in[9] + l * 4; isg = true; break;
                case 2: g = pg8::Gemm{WIN + (size_t)N_RM * DM, H, N_TR, TC, DM, DM, DM}; E.o0 = (bf16_t*)(ws + WS_VT); E.ld0 = LDVT; isg = true; break;
                case 3: g = pg8::Gemm{(bf16_t*)(ws + WS_CKV), (bf16_t*)(ws + WS_WC1), 4096, 256, 2048, 1024, 2048}; E.mode = pg8::M_CMP1; E.o0 = (bf16_t*)(ws + WS_HID); E.f1 = ctlf + CF_PEB; isg = true; break;
                case 4: g = pg8::Gemm{PRM + C_BCQ, (bf16_t*)(ws + WS_WUQ), TC, 768, 256, LDP, 256}; E.mode = pg8::M_QF; E.o0 = (bf16_t*)(ws + WS_QF); isg = true; break;
                case 5: g = pg8::Gemm{PRM + C_BCKV, WUKV, TC, 512, 256, LDP, 256}; E.o0 = (bf16_t*)(ws + WS_KN); E.ld0 = 512; isg = true; break;
                case 6: g = pg8::Gemm{WUKV + 512 * 256, PRM + C_BCKV, 512, TC, 256, 256, LDP}; E.o0 = (bf16_t*)(ws + WS_MVT); E.ld0 = LDVT; isg = true; break;
                case 8: case 9: case 10: case 11: { const int n = s - 8; const int yc = (n == 0) ? C_AQ : (n == 1) ? C_YB : (n == 2) ? C_CQ : C_DQ;
                    g = pg8::Gemm{PRM + yc, (bf16_t*)(ws + WS_WBR) + (size_t)n * 1024 * 512, TC, DM, 512, LDP, 512}; E.mode = pg8::M_MERGE; E.aux = n; E.o0 = MRG; E.o1 = GATES; isg = true; } break;
                case 12: g = pg8::Gemm{MRG, (bf16_t*)(ws + WS_WOUT), TC, DM, DM, DM, DM}; E.mode = pg8::M_OUT; E.f0 = p.out + tok0 * DM; E.f1 = xin + tok0 * DM; isg = true; break;
                case 14: g = pg8::Gemm{H, (bf16_t*)(ws + WS_WUP), TC, 2 * DFF, DM, DM, DM}; E.o0 = (bf16_t*)(ws + WS_U); E.ld0 = 2 * DFF; isg = true; break;
                case 16: g = pg8::Gemm{(bf16_t*)(ws + WS_ACT), (bf16_t*)(ws + WS_WDN), TC, DM, DFF, DFF, DFF}; E.mode = pg8::M_DOWN; E.f0 = p.out + tok0 * DM; isg = true; break;
                case 18: g = pg8::Gemm{(bf16_t*)(ws + WS_H8), (bf16_t*)(ws + WS_WG8), TC, 4096, DM / 2, DM / 2, DM / 2}; E.mode = pg8::M_GATE8; E.o1 = GATES; isg = true; break;
                case 17: g = pg8::Gemm{(bf16_t*)(ws + WS_HID), (bf16_t*)(ws + WS_WC2), 4096, 256, 128, 128, 128}; E.mode = pg8::M_CMP2; E.o0 = (bf16_t*)(ws + WS_KC); E.o1 = (bf16_t*)(ws + WS_VCT); isg = true; break;
                default: break;
                }
#ifndef NO_G
#ifndef PROBE_STEP
#define PROBE_STEP -1
#endif
                if (isg) { const int rot = (s == 2 || s == 5 || s == 17) ? 64 : (s == 6) ? 192 : 0;
                    pg8::StaticOrder S; S.init(g.M, g.N, G, (bid + rot) % G);
                    if (s == 18) pg8::gemm_phase<true>(lds, g, S, E, fresh_tid(wave0)); else pg8::gemm_phase<false>(lds, g, S, E, fresh_tid(wave0)); }
#endif
#define STEP_TID() const int tid = fresh_tid(wave0), lane = tid & 63, wave = wave0, gw = bid * 8 + wave, gtid = bid * 512 + tid; (void)lane; (void)gw; (void)gtid; (void)wave
                switch (s) {
                case 0: { STEP_TID();
                    if (l == 0 && c == 0 && bid < 3) {
                        LAS float* cst = (LAS float*)lds;
                        for (int u = tid; u < N_UNITS; u += 512) cst[u] = unit_cost(u);
                        if (gtid < 128) { unsigned zz; asm volatile("v_mov_b32 %0, 0" : "=v"(zz)); ((u32x4*)(ws + WS_CKV + (size_t)8 * MiB))[gtid] = (u32x4){zz, zz, zz, zz}; }
                        __syncthreads();
                        if (gtid < N_UNITS) { const float mine = cst[gtid]; int rank = 0;
                            for (int u = 0; u < N_UNITS; ++u) { const float cu = cst[u]; rank += (cu > mine || (cu == mine && u < gtid)) ? 1 : 0; }
                            ((int*)ctl)[CW_ORDER + rank] = gtid; }
                        __syncthreads();
                    }
                    if (c == 0) prologue_weights(p, l, lds, gw, ngw, wave, lane);
                    { const float* gmix = p.in[1] + l * DM;
                      for (int mrow = 2 * gw; mrow < TC; mrow += 2 * ngw) norm_row_bf16_x2(xin + (tok0 + mrow) * DM, xin + (tok0 + mrow + 1) * DM, gmix, H + (size_t)mrow * DM, H + (size_t)(mrow + 1) * DM, lane, ws + WS_H8 + (size_t)mrow * DM, ws + WS_H8 + (size_t)(mrow + 1) * DM); }
                    } break;
                case 3: { STEP_TID();
                    { const float* gq = p.in[5] + l * 256; const float* gkv = p.in[7] + l * 256;
                      for (int it = 4 * gw; it < 2 * TC; it += 4 * ngw) {
                        bf16_t* const rr[4] = {PRM + (size_t)(it >> 1) * LDP + C_BCQ, PRM + (size_t)(it >> 1) * LDP + C_BCQ + 256, PRM + (size_t)((it >> 1) + 1) * LDP + C_BCQ, PRM + (size_t)((it >> 1) + 1) * LDP + C_BCQ + 256};
                        const float* const gg[4] = {gq, gkv, gq, gkv};
                        norm256_inplace_x4(rr, gg, lane); } }
                    if (bid >= G - 16) cumsum_block((const float*)(ws + WS_LOGF), (float*)(ws + WS_CUM), bid - (G - 16), tid, (LAS float*)(lds + 131072));
                    } break;
                case 7: {
#ifndef ATT_REPS
#define ATT_REPS 1
#endif
                    for (int rep = 0; rep < ATT_REPS; ++rep) {
                    const bool dummy = rep + 1 < ATT_REPS;
                    unsigned* ctr = ctl + CW_ATT + 64 * (l * 2 + c) + rep;
                    LAS int* sidx = (LAS int*)(lds + LDS_MISC);
                    for (;;) {
                        const int tid = fresh_tid(wave0);
                        if (tid == 0) *sidx = (int)atomicAdd(ctr, 1u);
                        __syncthreads();
                        const int idx = __builtin_amdgcn_readfirstlane(*sidx);
                        __syncthreads();
                        if (idx >= N_UNITS) break;
                        const int un = __builtin_amdgcn_readfirstlane(((const int*)ctl)[CW_ORDER + idx]);
                        if (un < 768) {
                            const int qb = un / 48, rem = un % 48, type = rem >> 4, bh = rem & 15, bloc = bh >> 2, hd = bh & 3;
#ifndef NO_A
                            if (type == 0) abc_unit<0>(p, l, bloc, hd, qb, lds, tid, dummy);
#endif
#ifndef NO_B
                            if (type == 1) abc_unit<1>(p, l, bloc, hd, qb, lds, tid, dummy);
#endif
#ifndef NO_C
                            if (type == 2) abc_unit<2>(p, l, bloc, hd, qb, lds, tid, dummy);
#endif
                        } else {
                            const int i2 = un - 768, qblk = i2 >> 3, rem = i2 & 7;
#ifndef NO_D
                            nsa_unit(p, l, rem >> 1, rem & 1, qblk, lds, tid, dummy);
#endif
                        }
                    }
                    }
                } break;
                case 13: { STEP_TID();
                    { const float* gffn = p.in[15] + l * DM;
                      for (int mrow = 2 * gw; mrow < TC; mrow += 2 * ngw) norm_row_bf16_x2(p.out + (tok0 + mrow) * DM, p.out + (tok0 + mrow + 1) * DM, gffn, H + (size_t)mrow * DM, H + (size_t)(mrow + 1) * DM, lane); }
                    } break;
                case 15: { STEP_TID(); conv_phase(p, l, gtid, gthreads); } break;
                default: break;
                }
                const bool sync_after = (s_ == 19) || !(s == 1 || s == 18 || s == 4 || s == 5 || s == 6 || s == 8 || s == 9 || s == 10);
                if (sync_after) { if (l == 0 && c == 0 && s_ == 0) grid.sync(); else { XcdBarrier xb; xb.bar = ctl + CW_BAR; xb.x = xb_xcc_id(); xb.st = (volatile LAS unsigned*)(lds + LDS_MISC + 64); xcd_barrier(xb, fresh_tid(wave0)); } }
            }
        }
    }
    { const int lane = (int)__builtin_amdgcn_mbcnt_hi(~0u, __builtin_amdgcn_mbcnt_lo(~0u, 0u)), gw = bid * 8 + wave0;
      const float* gfin = p.in[20];
      for (int mrow = 2 * gw; mrow < TALL; mrow += 2 * ngw) {
        float* x0 = p.out + (size_t)mrow * DM; float* x1 = x0 + DM;
        f32x4 v[2][4]; float s[2] = {0.f, 0.f};
#pragma unroll
        for (int k = 0; k < 2; ++k)
#pragma unroll
            for (int j = 0; j < 4; ++j) v[k][j] = ((const f32x4*)(k ? x1 : x0))[64 * j + lane];
#pragma unroll
        for (int k = 0; k < 2; ++k)
#pragma unroll
            for (int j = 0; j < 4; ++j) s[k] += (v[k][j].x * v[k][j].x + v[k][j].y * v[k][j].y) + (v[k][j].z * v[k][j].z + v[k][j].w * v[k][j].w);
#pragma unroll
        for (int k = 0; k < 2; ++k) { const float rs = 1.f / sqrtf(wave_sum(s[k]) * (1.f / DM) + EPS);
#pragma unroll
            for (int j = 0; j < 4; ++j) { const f32x4 gg = ((const f32x4*)gfin)[64 * j + lane];
                ((f32x4*)(k ? x1 : x0))[64 * j + lane] = (f32x4){v[k][j].x * rs * gg.x, v[k][j].y * rs * gg.y, v[k][j].z * rs * gg.z, v[k][j].w * rs * gg.w}; } }
      } }
}

extern "C" void kernel_launch(void* const* d_in, const int* in_sizes, int n_in, void* d_out, int out_size, void* d_ws, size_t ws_size, hipStream_t stream) {
    static int grid = 0;
    if (grid == 0) {
        if (n_in != 21 || out_size != TALL * DM || ws_size < WS_END) { fprintf(stderr, "kernel_launch: unexpected shapes (n_in %d out %d ws %zu)\n", n_in, out_size, ws_size); grid = -1; return; }
        int dev = 0, cus = 0, per_cu = 0;
        (void)hipGetDevice(&dev);
        (void)hipDeviceGetAttribute(&cus, hipDeviceAttributeMultiprocessorCount, dev);
        if (hipFuncSetAttribute((const void*)mega_fwd, hipFuncAttributeMaxDynamicSharedMemorySize, LDS_BYTES) != hipSuccess) { fprintf(stderr, "kernel_launch: hipFuncSetAttribute failed\n"); }
        if (hipOccupancyMaxActiveBlocksPerMultiprocessor(&per_cu, (const void*)mega_fwd, 512, LDS_BYTES) != hipSuccess || per_cu < 1) { fprintf(stderr, "kernel_launch: occupancy query gave %d\n", per_cu); per_cu = 1; }
        (void)hipGetLastError();
        grid = cus * 1;
    }
    if (grid < 0) return;
    (void)hipMemsetAsync(d_ws, 0, 32768, stream);
    Params p{};
    for (int i = 0; i < 21; ++i) p.in[i] = (const float*)d_in[i];
    p.out = (float*)d_out; p.ws = (unsigned char*)d_ws;
    void* args[] = {&p};
    hipError_t e = hipLaunchCooperativeKernel((const void*)mega_fwd, dim3(grid), dim3(512), args, LDS_BYTES, stream);
    if (e != hipSuccess) fprintf(stderr, "cooperative launch failed: %s (grid %d)\n", hipGetErrorString(e), grid);
}
```

```cpp
#include <hip/hip_runtime.h>
#include <hip/hip_cooperative_groups.h>
#include <cstdio>
#include <cstdint>
namespace cg = cooperative_groups;

#define DI __device__ __forceinline__
#define LAS __attribute__((address_space(3)))
typedef unsigned short bf16_t;
typedef short bf16x8 __attribute__((ext_vector_type(8)));
typedef short s16x4 __attribute__((ext_vector_type(4)));
typedef float f32x4 __attribute__((ext_vector_type(4)));
typedef float f32x16 __attribute__((ext_vector_type(16)));
typedef unsigned u32x4 __attribute__((ext_vector_type(4)));
typedef unsigned u32x2 __attribute__((ext_vector_type(2)));
typedef float f32x2_t __attribute__((ext_vector_type(2)));
typedef __bf16 bf16x2_t __attribute__((ext_vector_type(2)));

DI unsigned cvtpk(float lo, float hi) { f32x2_t v = {lo, hi}; bf16x2_t b = __builtin_convertvector(v, bf16x2_t); return __builtin_bit_cast(unsigned, b); }
DI float bflo(unsigned u) { return __uint_as_float(u << 16); }
DI float bfhi(unsigned u) { return __uint_as_float(u & 0xffff0000u); }
DI float bf2f(bf16_t u) { return __uint_as_float(((unsigned)u) << 16); }
DI float sigmoidf_(float x) { return __builtin_amdgcn_rcpf(1.f + __builtin_amdgcn_exp2f(-1.4426950408889634f * x)); }
template <int M> DI unsigned swz_xor(unsigned v) { return (unsigned)__builtin_amdgcn_ds_swizzle((int)v, (M << 10) | 0x1f); }
DI float hsum32(float v) { auto rr = __builtin_amdgcn_permlane32_swap(__float_as_uint(v), __float_as_uint(v), false, false); return __uint_as_float(rr[0]) + __uint_as_float(rr[1]); }
DI unsigned hor32(unsigned v) { auto rr = __builtin_amdgcn_permlane32_swap(v, v, false, false); return rr[0] | rr[1]; }
DI float wave_sum(float v) {
    v += __uint_as_float(swz_xor<1>(__float_as_uint(v))); v += __uint_as_float(swz_xor<2>(__float_as_uint(v))); v += __uint_as_float(swz_xor<4>(__float_as_uint(v)));
    v += __uint_as_float(swz_xor<8>(__float_as_uint(v))); v += __uint_as_float(swz_xor<16>(__float_as_uint(v)));
    return hsum32(v);
}
DI unsigned wave_or(unsigned v) { v |= swz_xor<1>(v); v |= swz_xor<2>(v); v |= swz_xor<4>(v); v |= swz_xor<8>(v); v |= swz_xor<16>(v); return hor32(v); }

DI int fresh_tid(int wave0) { unsigned z_; asm volatile("v_mov_b32 %0, 0" : "=v"(z_)); return wave0 * 64 + (int)__builtin_amdgcn_mbcnt_hi(~0u, __builtin_amdgcn_mbcnt_lo(~0u, z_)); }

constexpr int SEQ = 4096, DM = 1024, NB = 8, TALL = NB * SEQ;
constexpr int BC = 4, TC = BC * SEQ, NCHUNK = 2;
constexpr int NIN = 9052, DFF = 2816;
constexpr int LDP = 3840;
constexpr int C_AQ = 0, C_AK = 512, C_BCQ = 1024, C_BCKV = 1280, C_CQ = 1536, C_CK = 2048, C_DQ = 2560, C_DKS = 3072, C_DKW = 3200,
              C_CMP = 3328, C_KR = 3584, C_CF = 3648, C_DG = 3656, C_GATE = 3840, N_RM = 7936, N_TR = 1280;
constexpr int C_YB = 1024;
constexpr int R_AV = 0, R_CV = 512, R_DVS = 1024, R_DVW = 1152;
constexpr float LOG2E = 1.4426950408889634f;
constexpr float EPS = 1e-6f;

constexpr size_t MiB = 1ull << 20;
constexpr size_t WS_CTL = 0;
constexpr size_t WS_WIN = 1 * MiB;
constexpr size_t WS_WUQ = 19 * MiB;
constexpr size_t WS_WUKV = WS_WUQ + 512 * 1024;
constexpr size_t WS_WBR = 20 * MiB;
constexpr size_t WS_WOUT = 24 * MiB;
constexpr size_t WS_WUP = 26 * MiB;
constexpr size_t WS_WDN = 37 * MiB;
constexpr size_t WS_WC1 = 43 * MiB;
constexpr size_t WS_WC2 = 44 * MiB;
constexpr size_t WS_H = 48 * MiB;
constexpr size_t WS_PRM = 80 * MiB;
constexpr size_t WS_GATES = 200 * MiB;
constexpr int LDVT = TC + 64;
constexpr size_t WS_VT = 328 * MiB;
constexpr size_t WS_QF = 369 * MiB;
constexpr size_t WS_KN = 393 * MiB;
constexpr size_t WS_MVT = 409 * MiB;
constexpr size_t WS_CKV = 426 * MiB;
constexpr size_t WS_HID = 435 * MiB;
constexpr size_t WS_KC = 436 * MiB;
constexpr size_t WS_VCT = WS_KC + 256 * 1024;
constexpr size_t WS_LOGF = WS_KC + 512 * 1024;
constexpr size_t WS_CUM = WS_KC + 768 * 1024;
constexpr size_t WS_MRG = 438 * MiB;
constexpr size_t WS_H8 = 470 * MiB;
constexpr size_t WS_WG8 = 486 * MiB;
constexpr size_t WS_END = 490 * MiB;
constexpr size_t WS_U = WS_PRM;
constexpr size_t WS_ACT = WS_PRM + 176 * MiB;
constexpr int CW_ATT = 16;
constexpr int CW_BAR = 2048;
constexpr int CF_LAM = 1024;
constexpr int CF_PEB = 1088;

struct Params {
    const float* in[21];
    float* out;
    unsigned char* ws;
};

namespace pg8 {
constexpr int BM = 256, BK = 64, HALF = 128, HTB = HALF * BK * 2, STAGE_BYTES = 8 * HTB, NXCD = 8, WGM = 8;
DI int lds_byte(int r, int c) { const int st = (r >> 4) * 2 + (c >> 5), rr = r & 15, cc = c & 31, ob = rr * 64 + cc * 2; return st * 1024 + (ob ^ (((ob >> 9) & 1) << 5)); }
DI void stage_rc(int b, int& R, int& C) { const int st = b / 1024, sb = b % 1024, swz = sb ^ (((sb >> 9) & 1) << 5); R = (st >> 1) * 16 + swz / 64; C = (st & 1) * 32 + (swz % 64) / 2; }
DI int perm32(int rho) { const int n = rho >> 4, i = rho & 15; return 8 * (i >> 2) + 4 * n + (i & 3); }
struct Unit { int pm, pn; };
struct Gemm { const bf16_t* A; const bf16_t* Bt; int M, N, K, lda, ldb; };
struct StaticOrder {
    int nM, nN, nwg, G, c;
    DI void init(int M, int N, int G_, int c_) { nM = M / BM; nN = N / BM; nwg = nM * nN; G = G_; c = c_; }
    DI bool next(int i, Unit& u) const {
        const long L = (long)i * G + c; if (L >= nwg) return false;
        int wgid = (int)L; { const int q = nwg / NXCD, r = nwg % NXCD, xcd = wgid % NXCD, off = wgid / NXCD; wgid = (xcd < r ? xcd * (q + 1) : r * (q + 1) + (xcd - r) * q) + off; }
        const int nig = WGM * nN, gid = wgid / nig, fm = gid * WGM, gsz = (nM - fm) < WGM ? (nM - fm) : WGM;
        u.pm = fm + ((wgid % nig) % gsz); u.pn = (wgid % nig) / gsz; return true;
    }
};

enum { M_PLAIN = 0, M_GATE8, M_INRM, M_QF, M_CMP1, M_CMP2, M_MERGE, M_OUT, M_DOWN };
struct Epi {
    int mode, aux;
    bf16_t* o0; int ld0;
    bf16_t* o1;
    bf16_t* o2;
    float* f0;
    const float* f1;
    DI void rope8(float (&v)[8], int pos, int i0) const {
#pragma unroll
        for (int p = 0; p < 4; ++p) {
            const float invf = __builtin_amdgcn_exp2f(-(float)(i0 + p) * 0.4152410118609203f);
            const float ang = (float)pos * invf; float rev = ang * 0.15915494309189535f; rev -= rintf(rev);
            const float cs = __builtin_amdgcn_cosf(rev), sn = __builtin_amdgcn_sinf(rev);
            const float a = v[2 * p], b = v[2 * p + 1];
            v[2 * p] = a * cs - b * sn; v[2 * p + 1] = b * cs + a * sn;
        }
    }
    DI void st8(bf16_t* p, const float (&v)[8]) const { u32x4 w; w.x = cvtpk(v[0], v[1]); w.y = cvtpk(v[2], v[3]); w.z = cvtpk(v[4], v[5]); w.w = cvtpk(v[6], v[7]); *(u32x4*)p = w; }
    DI void emit(int row, int col0, float (&v)[8]) const {
        switch (mode) {
        case M_PLAIN: st8(o0 + (size_t)row * ld0 + col0, v); break;
        case M_GATE8: {
#pragma unroll
            for (int j = 0; j < 8; ++j) v[j] = sigmoidf_(v[j] * (1.f / 1024.f)) * 255.f;
            unsigned w0 = __builtin_amdgcn_cvt_pk_u8_f32(v[0], 0, 0u); w0 = __builtin_amdgcn_cvt_pk_u8_f32(v[1], 1, w0); w0 = __builtin_amdgcn_cvt_pk_u8_f32(v[2], 2, w0); w0 = __builtin_amdgcn_cvt_pk_u8_f32(v[3], 3, w0);
            unsigned w1 = __builtin_amdgcn_cvt_pk_u8_f32(v[4], 0, 0u); w1 = __builtin_amdgcn_cvt_pk_u8_f32(v[5], 1, w1); w1 = __builtin_amdgcn_cvt_pk_u8_f32(v[6], 2, w1); w1 = __builtin_amdgcn_cvt_pk_u8_f32(v[7], 3, w1);
            *(u32x2*)((unsigned char*)o1 + (size_t)row * 4096 + col0) = (u32x2){w0, w1};
        } break;
        case M_INRM: {
            if (col0 >= C_GATE) {
#pragma unroll
                for (int j = 0; j < 8; ++j) v[j] = sigmoidf_(v[j]);
                st8(o1 + (size_t)row * 4096 + (col0 - C_GATE), v);
            } else if (col0 < C_CMP) {
                const float qs = (col0 < C_AK || (col0 >= C_DQ && col0 < C_DKS)) ? 0.125f * LOG2E : (col0 >= C_CQ && col0 < C_CK) ? 0.08838834764831845f * LOG2E : 1.f;
#pragma unroll
                for (int j = 0; j < 8; ++j) v[j] *= qs;
                st8(o0 + (size_t)row * LDP + col0, v); }
            else if (col0 < C_KR) {
                const int cc = col0 - C_CMP, kvsel = cc >> 7, g = (cc >> 6) & 1, d0 = cc & 63, b = row >> 12, s = row & 4095;
                st8(o2 + ((size_t)((kvsel * 4 + b) * 2 + g) * SEQ + s) * 64 + d0, v);
            } else if (col0 < C_CF) { rope8(v, row & 4095, (col0 - C_KR) >> 1); st8(o0 + (size_t)row * LDP + col0, v); }
            else if (col0 == C_CF) {
                f32x4 o;
#pragma unroll
                for (int j = 0; j < 4; ++j) { const float x = v[j] + f1[j]; const float e = __expf(-fabsf(x)); float r = -__logf(1.f + e); if (x < 0.f) r += x; o[j] = r; }
                *(f32x4*)(f0 + (size_t)row * 4) = o;
            } else if (col0 < 3680) {
#pragma unroll
                for (int j = 0; j < 8; ++j) v[j] = sigmoidf_(v[j]);
                st8(o0 + (size_t)row * LDP + col0, v);
            }
        } break;
        case M_QF: { const int j = col0 % 192; if (j >= 128) rope8(v, row & 4095, (j - 128) >> 1);
#pragma unroll
            for (int i = 0; i < 8; ++i) v[i] *= 0.07216878364870322f * LOG2E;
            st8(o0 + (size_t)row * 768 + col0, v); } break;
        case M_CMP1: {
            const int kvsel = row >> 11;
            if ((col0 >> 7) == kvsel) { const int j = col0 & 127;
#pragma unroll
                for (int i = 0; i < 8; ++i) { const float x = v[i] + f1[kvsel * 128 + j + i]; const float u = 0.7978845608028654f * (x + 0.044715f * x * x * x);
                    const float t = 1.f - 2.f / (1.f + __expf(2.f * u)); v[i] = 0.5f * x * (1.f + t); }
                st8(o0 + (size_t)row * 128 + j, v); }
        } break;
        case M_CMP2: {
            const int kvsel = row >> 11, bg = (row >> 8) & 7, c = row & 255;
            if (kvsel == 0 && col0 < 64) st8(o0 + ((size_t)bg * 256 + c) * 64 + col0, v);
            else if (kvsel == 1 && col0 >= 64 && col0 < 128) {
#pragma unroll
                for (int i = 0; i < 8; ++i) o1[((size_t)bg * 64 + (col0 - 64 + i)) * 256 + c] = (bf16_t)(cvtpk(v[i], 0.f) & 0xffffu);
            }
        } break;
        case M_MERGE: {
            const u32x2 g = *(const u32x2*)((const unsigned char*)o1 + (size_t)row * 4096 + aux * 1024 + col0);
            bf16_t* mp = o0 + (size_t)row * 1024 + col0;
#pragma unroll
            for (int j = 0; j < 8; ++j) v[j] *= (1.f / 255.f);
            float m[8] = {0.f, 0.f, 0.f, 0.f, 0.f, 0.f, 0.f, 0.f};
            if (aux > 0) { const u32x4 o = *(const u32x4*)mp; m[0] = bflo(o.x); m[1] = bfhi(o.x); m[2] = bflo(o.y); m[3] = bfhi(o.y); m[4] = bflo(o.z); m[5] = bfhi(o.z); m[6] = bflo(o.w); m[7] = bfhi(o.w); }
            v[0] = m[0] + (float)(g.x & 0xffu) * v[0]; v[1] = m[1] + (float)((g.x >> 8) & 0xffu) * v[1]; v[2] = m[2] + (float)((g.x >> 16) & 0xffu) * v[2]; v[3] = m[3] + (float)(g.x >> 24) * v[3];
            v[4] = m[4] + (float)(g.y & 0xffu) * v[4]; v[5] = m[5] + (float)((g.y >> 8) & 0xffu) * v[5]; v[6] = m[6] + (float)((g.y >> 16) & 0xffu) * v[6]; v[7] = m[7] + (float)(g.y >> 24) * v[7];
            st8(mp, v);
        } break;
        case M_OUT: case M_DOWN: {
            const float* src = (mode == M_OUT) ? f1 : f0; const size_t off = (size_t)row * DM + col0;
            const f32x4 a = *(const f32x4*)(src + off), b = *(const f32x4*)(src + off + 4);
            *(f32x4*)(f0 + off) = (f32x4){a.x + v[0], a.y + v[1], a.z + v[2], a.w + v[3]};
            *(f32x4*)(f0 + off + 4) = (f32x4){b.x + v[4], b.y + v[5], b.z + v[6], b.w + v[7]};
        } break;
        }
    }
    DI void operator()(const f32x4 (&acc)[2][2][4][2], const Unit& u, int wr, int wc, int fr, int fq) const {
#pragma unroll
        for (int ai = 0; ai < 2; ++ai)
#pragma unroll
            for (int m = 0; m < 4; ++m) {
                const int row = u.pm * BM + ai * HALF + wr * 64 + m * 16 + fr;
#pragma unroll
                for (int bj = 0; bj < 2; ++bj) {
                    const int col0 = u.pn * BM + bj * HALF + wc * 32 + 8 * fq;
                    const f32x4 a = acc[ai][bj][m][0], b = acc[ai][bj][m][1];
                    float v[8] = {a.x, a.y, a.z, a.w, b.x, b.y, b.z, b.w};
                    emit(row, col0, v);
                    if (bj == 1 && (m & 1)) asm volatile("" ::: "memory");
                }
            }
    }
};

typedef int v4i_t __attribute__((ext_vector_type(4)));
typedef int v8i_t __attribute__((ext_vector_type(8)));
typedef long v2l_t __attribute__((ext_vector_type(2)));
template <bool FP8>
DI void gemm_phase(LAS unsigned char* lds, const Gemm g, const StaticOrder& S, const Epi& E, int tid) {
    asm volatile("" : "+v"(tid));
    const int wid = __builtin_amdgcn_readfirstlane(tid >> 6), lane = tid & 63, wr = wid >> 2, wc = wid & 3, fr = lane & 15, fq = lane >> 4;
    const int K = g.K, nt = K / BK;
    unsigned voffA[2], voffB[2];
#pragma unroll
    for (int i = 0; i < 2; ++i) { int R, C; stage_rc(tid * 16 + i * 8192, R, C); const int Rb = (R & ~31) + perm32(R & 31);
        voffA[i] = (unsigned)(R * g.lda + C) * 2u; voffB[i] = (unsigned)(Rb * g.ldb + C) * 2u; }
    const unsigned kstep = (unsigned)(BK * 2);
    const unsigned hA = (unsigned)HALF * g.lda * 2u, hB = (unsigned)HALF * g.ldb * 2u;
    const unsigned tA = 2u * hA, tB = 2u * hB;
    const char* const Ab = (const char*)g.A; const char* const Bb = (const char*)g.Bt;
    const unsigned ldsw = (unsigned)wid * 1024u;
    const int aoff = lds_byte(wr * 64 + fr, fq * 8), boff = lds_byte(wc * 32 + fr, fq * 8);
#define PG8_SA(b, h) (((b) * 2 + (h)) * HTB)
#define PG8_SB(b, h) ((4 + (b) * 2 + (h)) * HTB)
#define PG8_STAGE(bufoff, gbase, voff) do { _Pragma("unroll") for (int _i = 0; _i < 2; ++_i) \
        __builtin_amdgcn_global_load_lds((const unsigned*)((gbase) + (voff)[_i]), (LAS unsigned*)(lds + (bufoff) + ldsw + _i * 8192), 16, 0, 0); } while (0)
#define PG8_LD8(addr_) __builtin_shufflevector(*(const LAS v4i_t*)(addr_), *(const LAS v4i_t*)((addr_) + 1024), 0, 1, 2, 3, 4, 5, 6, 7)
#define PG8_LDA(dst, b, h) do { _Pragma("unroll") for (int m = 0; m < 4; ++m) { if constexpr (FP8) dst##8[m] = PG8_LD8(lds + PG8_SA(b, h) + aoff + m * 2048); \
        else { _Pragma("unroll") for (int k = 0; k < 2; ++k) dst[m][k] = *(const LAS bf16x8*)(lds + PG8_SA(b, h) + aoff + m * 2048 + k * 1024); } } } while (0)
#define PG8_LDB(dst, b, h) do { _Pragma("unroll") for (int n = 0; n < 2; ++n) { if constexpr (FP8) dst##8[n] = PG8_LD8(lds + PG8_SB(b, h) + boff + n * 2048); \
        else { _Pragma("unroll") for (int k = 0; k < 2; ++k) dst[n][k] = *(const LAS bf16x8*)(lds + PG8_SB(b, h) + boff + n * 2048 + k * 1024); } } } while (0)
#define PG8_MMA(ai, bj, At, Bt) do { __builtin_amdgcn_s_setprio(1); \
        if constexpr (FP8) { _Pragma("unroll") for (int m = 0; m < 4; ++m) _Pragma("unroll") for (int n = 0; n < 2; ++n) \
            acc[ai][bj][m][n] = __builtin_amdgcn_mfma_scale_f32_16x16x128_f8f6f4(Bt##8[n], At##8[m], acc[ai][bj][m][n], 0, 0, 0, 0x7f7f7f7f, 0, 0x7f7f7f7f); } \
        else { _Pragma("unroll") for (int m = 0; m < 4; ++m) _Pragma("unroll") for (int n = 0; n < 2; ++n) _Pragma("unroll") for (int k = 0; k < 2; ++k) \
            acc[ai][bj][m][n] = __builtin_amdgcn_mfma_f32_16x16x32_bf16(Bt[n][k], At[m][k], acc[ai][bj][m][n], 0, 0, 0); } __builtin_amdgcn_s_setprio(0); } while (0)
#define PG8_WAIT_V(n) asm volatile("s_waitcnt vmcnt(" #n ")" ::: "memory")
#define PG8_WAIT_L(n) asm volatile("s_waitcnt lgkmcnt(" #n ")" ::: "memory")
#define PG8_BAR __builtin_amdgcn_s_barrier()
#define PG8_SCHED __builtin_amdgcn_sched_barrier(0)
    Unit cur, nxt; int ui = 0;
    if (!S.next(0, cur)) return;
    f32x4 acc[2][2][4][2];
#pragma unroll
    for (int a = 0; a < 2; ++a)
#pragma unroll
        for (int b = 0; b < 2; ++b)
#pragma unroll
            for (int m = 0; m < 4; ++m)
#pragma unroll
                for (int n = 0; n < 2; ++n) acc[a][b][m][n] = (f32x4){0.f, 0.f, 0.f, 0.f};
    bf16x8 At[4][2], B0[2][2], B1[2][2];
    v8i_t At8[4], B08[2], B18[2];
    unsigned cA = (unsigned)cur.pm * tA, cB = (unsigned)cur.pn * tB;
#define GA(o) (Ab + (o))
#define GB(o) (Bb + (o))
    PG8_STAGE(PG8_SB(0, 0), GB(cB), voffB); PG8_STAGE(PG8_SB(0, 1), GB(cB + hB), voffB); PG8_STAGE(PG8_SA(0, 0), GA(cA), voffA); PG8_STAGE(PG8_SA(0, 1), GA(cA + hA), voffA);
    if (wr == 1) PG8_BAR;
    PG8_WAIT_V(2); PG8_BAR;
    PG8_STAGE(PG8_SB(1, 0), GB(cB + kstep), voffB); PG8_STAGE(PG8_SA(1, 0), GA(cA + kstep), voffA); PG8_STAGE(PG8_SB(1, 1), GB(cB + hB + kstep), voffB);
    PG8_WAIT_V(6); PG8_BAR;
    for (;;) {
        const bool has_next = S.next(ui + 1, nxt);
        const unsigned nA = has_next ? (unsigned)nxt.pm * tA : cA, nB = has_next ? (unsigned)nxt.pn * tB : cB;
        for (int t = 0; t < nt; t += 2) {
            const bool last = (t == nt - 2);
            const unsigned a1 = cA + (unsigned)(t + 1) * kstep;
            const unsigned a2 = last ? nA : cA + (unsigned)(t + 2) * kstep, b2 = last ? nB : cB + (unsigned)(t + 2) * kstep;
            const unsigned a3 = a2 + kstep, b3 = b2 + kstep;
            PG8_LDB(B0, 0, 0); PG8_LDB(B1, 0, 1); PG8_SCHED; PG8_LDA(At, 0, 0); PG8_STAGE(PG8_SA(1, 1), GA(a1 + hA), voffA);
            PG8_WAIT_V(8); PG8_WAIT_L(0); PG8_BAR; PG8_MMA(0, 0, At, B0); PG8_MMA(0, 1, At, B1); PG8_BAR; PG8_SCHED;
            PG8_LDA(At, 0, 1); PG8_STAGE(PG8_SB(0, 0), GB(b2), voffB); PG8_STAGE(PG8_SB(0, 1), GB(b2 + hB), voffB); PG8_STAGE(PG8_SA(0, 0), GA(a2), voffA);
            PG8_WAIT_V(8); PG8_WAIT_L(0); PG8_BAR; PG8_MMA(1, 0, At, B0); PG8_MMA(1, 1, At, B1); PG8_BAR; PG8_SCHED;
            PG8_LDB(B0, 1, 0); PG8_LDB(B1, 1, 1); PG8_SCHED; PG8_LDA(At, 1, 0); PG8_STAGE(PG8_SA(0, 1), GA(a2 + hA), voffA);
            PG8_WAIT_V(8); PG8_WAIT_L(0); PG8_BAR; PG8_MMA(0, 0, At, B0); PG8_MMA(0, 1, At, B1); PG8_BAR; PG8_SCHED;
            PG8_LDA(At, 1, 1); PG8_STAGE(PG8_SB(1, 0), GB(b3), voffB); PG8_STAGE(PG8_SB(1, 1), GB(b3 + hB), voffB); PG8_STAGE(PG8_SA(1, 0), GA(a3), voffA);
            PG8_WAIT_V(8); PG8_WAIT_L(0); PG8_BAR; PG8_MMA(1, 0, At, B0); PG8_MMA(1, 1, At, B1); PG8_BAR; PG8_SCHED;
        }
        if (wr == 0) PG8_BAR;
        E(acc, cur, wr, wc, fr, fq);
        if (!has_next) break;
#pragma unroll
        for (int a = 0; a < 2; ++a)
#pragma unroll
            for (int b = 0; b < 2; ++b)
#pragma unroll
                for (int m = 0; m < 4; ++m)
#pragma unroll
                    for (int n = 0; n < 2; ++n) acc[a][b][m][n] = (f32x4){0.f, 0.f, 0.f, 0.f};
        cur = nxt; cA = nA; cB = nB; ++ui;
        if (wr == 1) PG8_BAR;
    }
    PG8_WAIT_V(0);
    PG8_BAR;
#undef GA
#undef GB
#undef PG8_SA
#undef PG8_SB
#undef PG8_STAGE
#undef PG8_LDA
#undef PG8_LD8
#undef PG8_LDB
#undef PG8_MMA
#undef PG8_WAIT_V
#undef PG8_WAIT_L
#undef PG8_BAR
#undef PG8_SCHED
}
}

DI unsigned pk4_fp8(float a, float b, float c, float d) {
    float mx; asm volatile("v_mov_b32 %0, 0x43e00000" : "=v"(mx));
    a = __builtin_fminf(__builtin_fmaxf(a, -mx), mx); b = __builtin_fminf(__builtin_fmaxf(b, -mx), mx); c = __builtin_fminf(__builtin_fmaxf(c, -mx), mx); d = __builtin_fminf(__builtin_fmaxf(d, -mx), mx);
    int w = __builtin_amdgcn_cvt_pk_fp8_f32(a, b, 0, false); w = __builtin_amdgcn_cvt_pk_fp8_f32(c, d, w, true); return (unsigned)w; }
DI int map_in(int n) {
    if (n < 1024) return n;
    if (n < 1280) return 1536 + (n - 1024);
    if (n < 1536) return 1792 + (n - 1280);
    if (n < 2048) return 2112 + (n - 1536);
    if (n < 2560) return 2624 + (n - 2048);
    if (n < 3072) return 3652 + (n - 2560);
    if (n < 3200) return 4420 + (n - 3072);
    if (n < 3328) return 4676 + (n - 3200);
    if (n < 3456) return 4164 + (n - 3328);
    if (n < 3584) return 4292 + (n - 3456);
    if (n < 3648) { const int j = n - 3584; return 2048 + (j >> 1) + ((j & 1) ? 32 : 0); }
    if (n < 3652) return n;
    if (n < 3656) return -1;
    if (n < 3680) return 4932 + (n - 3656);
    if (n < 3840) return -1;
    if (n < 7936) return 4956 + (n - 3840);
    n -= 7936;
    if (n < 512) return 1024 + n;
    if (n < 1024) return 3136 + (n - 512);
    if (n < 1152) return 4548 + (n - 1024);
    return 4804 + (n - 1152);
}
DI int map_col(int mapid, int n) {
    switch (mapid) {
    case 1: return map_in(n);
    case 2: { const int h = n / 192, j = n % 192; if (j < 128) return n; const int jj = j - 128; return h * 192 + 128 + (jj >> 1) + ((jj & 1) ? 32 : 0); }
    case 3: { if (n < 512) { return (n >> 7) * 256 + (n & 127); } const int m = n - 512; return (m >> 7) * 256 + 128 + (m & 127); }
    default: return n;
    }
}
DI void tr_item(const float* W, int ldw, int K, bf16_t* WT, int nblk, int item, int mapid, LAS float* scr, int lane) {
    const int kb = item / nblk, nb = item % nblk, k0 = 64 * kb, n0 = 32 * nb;
    const int sc = map_col(mapid, n0 + (lane & 31));
    float tv[32];
#pragma unroll
    for (int i = 0; i < 32; ++i) { const int kk = 2 * i + (lane >> 5); tv[i] = (sc >= 0) ? W[(size_t)(k0 + kk) * ldw + sc] : 0.f; }
#pragma unroll
    for (int i = 0; i < 32; ++i) { const int kk = 2 * i + (lane >> 5); scr[kk * 33 + (lane & 31)] = tv[i]; }
    asm volatile("s_waitcnt lgkmcnt(0)" ::: "memory");
    const int c = lane & 7;
#pragma unroll
    for (int j = 0; j < 4; ++j) { const int n = (lane >> 3) + 8 * j; const LAS float* s = scr + (8 * c) * 33 + n;
        u32x4 o; o.x = cvtpk(s[0 * 33], s[1 * 33]); o.y = cvtpk(s[2 * 33], s[3 * 33]); o.z = cvtpk(s[4 * 33], s[5 * 33]); o.w = cvtpk(s[6 * 33], s[7 * 33]);
        *(u32x4*)(WT + (size_t)(n0 + n) * K + k0 + 8 * c) = o; }
    asm volatile("s_waitcnt lgkmcnt(0)" ::: "memory");
}

DI void tr_item_fp8(const float* W, int ldw, int K, unsigned char* WT, int nblk, int item, int col_off, float sc, LAS float* scr, int lane) {
    const int kb = item / nblk, nb = item % nblk, k0 = 64 * kb, n0 = 32 * nb;
    float tv[32];
#pragma unroll
    for (int i = 0; i < 32; ++i) { const int kk = 2 * i + (lane >> 5); tv[i] = W[(size_t)(k0 + kk) * ldw + col_off + n0 + (lane & 31)]; }
#pragma unroll
    for (int i = 0; i < 32; ++i) { const int kk = 2 * i + (lane >> 5); scr[kk * 33 + (lane & 31)] = tv[i] * sc; }
    asm volatile("s_waitcnt lgkmcnt(0)" ::: "memory");
    const int c = lane & 7;
#pragma unroll
    for (int j = 0; j < 4; ++j) { const int n = (lane >> 3) + 8 * j; const LAS float* s = scr + (8 * c) * 33 + n;
        u32x2 o; o.x = pk4_fp8(s[0 * 33], s[1 * 33], s[2 * 33], s[3 * 33]); o.y = pk4_fp8(s[4 * 33], s[5 * 33], s[6 * 33], s[7 * 33]);
        *(u32x2*)(WT + (size_t)(n0 + n) * K + k0 + 8 * c) = o; }
    asm volatile("s_waitcnt lgkmcnt(0)" ::: "memory");
}
DI void prologue_weights(const Params& p, int l, LAS unsigned char* lds, int gw, int ngw, int wave, int lane) {
    LAS float* scr = (LAS float*)(lds + wave * 16384);
    unsigned char* ws = p.ws;
    const float* w_in = p.in[2] + (size_t)l * DM * NIN;
    const float* w_uq = p.in[6] + (size_t)l * 256 * 768;
    const float* w_ukv = p.in[8] + (size_t)l * 256 * 1024;
    const float* w_br = p.in[13] + (size_t)l * 4 * 512 * 1024;
    const float* w_out = p.in[14] + (size_t)l * DM * DM;
    const float* w_up = p.in[16] + (size_t)l * DM * 2 * DFF;
    const float* w_dn = p.in[19] + (size_t)l * DFF * DM;
    const float* w_c1 = p.in[11] + (size_t)l * 2 * 2048 * 128;
    constexpr int I_IN = 16 * 288, I_UQ = 4 * 24, I_UKV = 4 * 32, I_BR = 8 * 32, I_OUT = 16 * 32, I_UP = 16 * 176, I_DN = 44 * 32, I_C1 = 32 * 4;
    constexpr int I_C2 = 2 * 2;
    const float* w_c2 = p.in[12] + (size_t)l * 2 * 128 * 64;
    constexpr int I_G8 = 16 * 128;
    constexpr int NITEMS = I_IN + I_UQ + I_UKV + 4 * I_BR + I_OUT + I_UP + I_DN + 2 * I_C1 + 2 * I_C2 + I_G8;
    for (int it = gw; it < NITEMS; it += ngw) {
        int r = it;
        if (r < I_IN) { const int nb_ = r % 288; if (nb_ < 120 || nb_ >= 248) tr_item(w_in, NIN, DM, (bf16_t*)(ws + WS_WIN), 288, r, 1, scr, lane); continue; } r -= I_IN;
        if (r < I_UQ) { tr_item(w_uq, 768, 256, (bf16_t*)(ws + WS_WUQ), 24, r, 2, scr, lane); continue; } r -= I_UQ;
        if (r < I_UKV) { tr_item(w_ukv, 1024, 256, (bf16_t*)(ws + WS_WUKV), 32, r, 3, scr, lane); continue; } r -= I_UKV;
        if (r < 4 * I_BR) { const int n = r / I_BR; tr_item(w_br + (size_t)n * 512 * 1024, 1024, 512, (bf16_t*)(ws + WS_WBR) + (size_t)n * 1024 * 512, 32, r % I_BR, 0, scr, lane); continue; } r -= 4 * I_BR;
        if (r < I_OUT) { tr_item(w_out, DM, DM, (bf16_t*)(ws + WS_WOUT), 32, r, 0, scr, lane); continue; } r -= I_OUT;
        if (r < I_UP) { tr_item(w_up, 2 * DFF, DM, (bf16_t*)(ws + WS_WUP), 176, r, 0, scr, lane); continue; } r -= I_UP;
        if (r < I_DN) { tr_item(w_dn, DM, DFF, (bf16_t*)(ws + WS_WDN), 32, r, 0, scr, lane); continue; } r -= I_DN;
        if (r < 2 * I_C1) { const int n = r / I_C1; tr_item(w_c1 + (size_t)n * 2048 * 128, 128, 2048, (bf16_t*)(ws + WS_WC1) + (size_t)n * 128 * 2048, 4, r % I_C1, 0, scr, lane); continue; } r -= 2 * I_C1;
        if (r < 2 * I_C2) { const int n = r / I_C2; tr_item(w_c2 + (size_t)n * 128 * 64, 64, 128, (bf16_t*)(ws + WS_WC2) + (size_t)n * 64 * 128, 2, r % I_C2, 0, scr, lane); continue; } r -= 2 * I_C2;
        tr_item_fp8(w_in, NIN, DM, ws + WS_WG8, 128, r, 4956, 64.f, scr, lane);
    }
    float* ctlf = (float*)(ws + WS_CTL);
    const float* pe = p.in[10] + (size_t)l * 2 * 2048;
    for (int o = gw; o < 256; o += ngw) {
        const int kvsel = o >> 7, j = o & 127; float s = 0.f;
#pragma unroll 8
        for (int k = lane; k < 2048; k += 64) s += pe[kvsel * 2048 + k] * w_c1[((size_t)kvsel * 2048 + k) * 128 + j];
        s = wave_sum(s); if (lane == 0) ctlf[CF_PEB + o] = s;
    }
    if (gw == ngw - 1) {
        const float* dl = p.in[3] + (size_t)l * 4 * 64;
        const float a = wave_sum(dl[lane] * dl[64 + lane]), b = wave_sum(dl[128 + lane] * dl[192 + lane]);
        int ll = l; asm volatile("" : "+s"(ll));
        const float lam_init = (ll == 0) ? 0.2f : 0.35550906759f;
        if (lane == 0) { ctlf[CF_LAM] = expf(a) - expf(b) + lam_init; ctlf[CF_LAM + 1] = lam_init; }
    }
}

DI void norm_row_bf16(const float* xr, const float* g, bf16_t* orow, int lane) {
    f32x4 v[4]; float s = 0.f;
#pragma unroll
    for (int j = 0; j < 4; ++j) { v[j] = ((const f32x4*)xr)[64 * j + lane]; s += (v[j].x * v[j].x + v[j].y * v[j].y) + (v[j].z * v[j].z + v[j].w * v[j].w); }
    const float rs = 1.f / sqrtf(wave_sum(s) * (1.f / DM) + EPS);
#pragma unroll
    for (int j = 0; j < 4; ++j) { const f32x4 gg = ((const f32x4*)g)[64 * j + lane];
        u32x2 o; o.x = cvtpk(v[j].x * rs * gg.x, v[j].y * rs * gg.y); o.y = cvtpk(v[j].z * rs * gg.z, v[j].w * rs * gg.w);
        ((u32x2*)orow)[64 * j + lane] = o; }
}
DI void norm_row_f32(float* xr, const float* g, int lane) {
    f32x4 v[4]; float s = 0.f;
#pragma unroll
    for (int j = 0; j < 4; ++j) { v[j] = ((const f32x4*)xr)[64 * j + lane]; s += (v[j].x * v[j].x + v[j].y * v[j].y) + (v[j].z * v[j].z + v[j].w * v[j].w); }
    const float rs = 1.f / sqrtf(wave_sum(s) * (1.f / DM) + EPS);
#pragma unroll
    for (int j = 0; j < 4; ++j) { const f32x4 gg = ((const f32x4*)g)[64 * j + lane];
        ((f32x4*)xr)[64 * j + lane] = (f32x4){v[j].x * rs * gg.x, v[j].y * rs * gg.y, v[j].z * rs * gg.z, v[j].w * rs * gg.w}; }
}
DI void norm256_inplace_x4(bf16_t* const (&r)[4], const float* const (&g)[4], int lane) {
    u32x2 w[4];
#pragma unroll
    for (int k = 0; k < 4; ++k) w[k] = ((const u32x2*)r[k])[lane];
#pragma unroll
    for (int k = 0; k < 4; ++k) {
        const float a = bflo(w[k].x), b = bfhi(w[k].x), c = bflo(w[k].y), d = bfhi(w[k].y);
        const float rs = 1.f / sqrtf(wave_sum((a * a + b * b) + (c * c + d * d)) * (1.f / 256.f) + EPS);
        const f32x4 gg = ((const f32x4*)g[k])[lane];
        u32x2 o; o.x = cvtpk(a * rs * gg.x, b * rs * gg.y); o.y = cvtpk(c * rs * gg.z, d * rs * gg.w);
        ((u32x2*)r[k])[lane] = o;
    }
}
DI void norm_row_bf16_x2(const float* x0, const float* x1, const float* g, bf16_t* o0, bf16_t* o1, int lane, unsigned char* q0 = nullptr, unsigned char* q1 = nullptr) {
    f32x4 v[2][4]; float s[2] = {0.f, 0.f};
#pragma unroll
    for (int k = 0; k < 2; ++k)
#pragma unroll
        for (int j = 0; j < 4; ++j) v[k][j] = ((const f32x4*)(k ? x1 : x0))[64 * j + lane];
#pragma unroll
    for (int k = 0; k < 2; ++k)
#pragma unroll
        for (int j = 0; j < 4; ++j) s[k] += (v[k][j].x * v[k][j].x + v[k][j].y * v[k][j].y) + (v[k][j].z * v[k][j].z + v[k][j].w * v[k][j].w);
#pragma unroll
    for (int k = 0; k < 2; ++k) {
        const float rs = 1.f / sqrtf(wave_sum(s[k]) * (1.f / DM) + EPS);
#pragma unroll
        for (int j = 0; j < 4; ++j) { const f32x4 gg = ((const f32x4*)g)[64 * j + lane];
            u32x2 o; o.x = cvtpk(v[k][j].x * rs * gg.x, v[k][j].y * rs * gg.y); o.y = cvtpk(v[k][j].z * rs * gg.z, v[k][j].w * rs * gg.w);
            ((u32x2*)(k ? o1 : o0))[64 * j + lane] = o;
            if (q0) ((unsigned*)(k ? q1 : q0))[64 * j + lane] = pk4_fp8(v[k][j].x * rs * gg.x * 16.f, v[k][j].y * rs * gg.y * 16.f, v[k][j].z * rs * gg.z * 16.f, v[k][j].w * rs * gg.w * 16.f); }
    }
}
DI void norm256_inplace(bf16_t* r, const float* g, int lane) {
    const u32x2 w = ((const u32x2*)r)[lane];
    float a = bflo(w.x), b = bfhi(w.x), c = bflo(w.y), d = bfhi(w.y);
    const float rs = 1.f / sqrtf(wave_sum((a * a + b * b) + (c * c + d * d)) * (1.f / 256.f) + EPS);
    const f32x4 gg = ((const f32x4*)g)[lane];
    u32x2 o; o.x = cvtpk(a * rs * gg.x, b * rs * gg.y); o.y = cvtpk(c * rs * gg.z, d * rs * gg.w);
    ((u32x2*)r)[lane] = o;
}
DI void cumsum_block(const float* logf  , float* cum  , int bh, int tid, LAS float* red  ) {
    const int b = bh >> 2, h = bh & 3, lane = tid & 63, wave = tid >> 6;
    const float* src = logf + ((size_t)b * SEQ + tid * 8) * 4 + h;
    float v[8]; float s = 0.f;
#pragma unroll
    for (int i = 0; i < 8; ++i) { v[i] = src[i * 4]; }
#pragma unroll
    for (int i = 0; i < 8; ++i) { s += v[i]; v[i] = s; }
    float inc = s;
#pragma unroll
    for (int o = 1; o < 64; o <<= 1) { const float t = __uint_as_float((unsigned)__builtin_amdgcn_ds_bpermute((lane - o) << 2, (int)__float_as_uint(inc))); if (lane >= o) inc += t; }
    if (lane == 63) red[wave] = inc;
    __syncthreads();
    float base = inc - s;
#pragma unroll
    for (int w = 0; w < 8; ++w) base += (w < wave) ? red[w] : 0.f;
    float* dst = cum + (size_t)bh * SEQ + tid * 8;
    *(f32x4*)dst = (f32x4){-(base + v[0]) * LOG2E, -(base + v[1]) * LOG2E, -(base + v[2]) * LOG2E, -(base + v[3]) * LOG2E};
    *(f32x4*)(dst + 4) = (f32x4){-(base + v[4]) * LOG2E, -(base + v[5]) * LOG2E, -(base + v[6]) * LOG2E, -(base + v[7]) * LOG2E};
    __syncthreads();
}
DI void cmp2_phase(const Params& p, int l, int gtid, int gthreads) {
    const bf16_t* hid = (const bf16_t*)(p.ws + WS_HID);
    bf16_t* kc = (bf16_t*)(p.ws + WS_KC); bf16_t* vct = (bf16_t*)(p.ws + WS_VCT);
    const float* w2 = p.in[12] + (size_t)l * 2 * 128 * 64;
    for (int idx = gtid; idx < 4096 * 64; idx += gthreads) {
        const int r = idx >> 6, j = idx & 63, kvsel = r >> 11, bg = (r >> 8) & 7, c = r & 255;
        const float* w = w2 + (size_t)kvsel * 128 * 64 + j; const bf16_t* hr = hid + (size_t)r * 128;
        float s = 0.f;
#pragma unroll 8
        for (int k = 0; k < 128; ++k) s += bf2f(hr[k]) * w[k * 64];
        const unsigned short o = (unsigned short)(cvtpk(s, 0.f) & 0xffffu);
        if (kvsel == 0) kc[((size_t)bg * 256 + c) * 64 + j] = o; else vct[((size_t)bg * 64 + j) * 256 + c] = o;
    }
}
constexpr int CONV_SEG = 45;
DI void conv_phase(const Params& p, int l, int gtid, int gthreads) {
    const bf16_t* U = (const bf16_t*)(p.ws + WS_U); bf16_t* ACT = (bf16_t*)(p.ws + WS_ACT);
    const float* cw = p.in[17] + (size_t)l * 3 * 2 * DFF; const float* cb = p.in[18] + (size_t)l * 2 * DFF;
    constexpr int FV = DFF / 8, NSEG = (TC + CONV_SEG - 1) / CONV_SEG;
    for (int idx = gtid; idx < NSEG * FV; idx += gthreads) {
        const int seg = idx / FV, f0 = (idx % FV) * 8, t0 = seg * CONV_SEG, t1 = (t0 + CONV_SEG < TC) ? t0 + CONV_SEG : TC;
        float wa[3][8], wg[3][8], ba[8], bg[8];
#pragma unroll
        for (int k = 0; k < 3; ++k) {
            const f32x4 a0 = *(const f32x4*)(cw + (size_t)k * 2 * DFF + f0), a1 = *(const f32x4*)(cw + (size_t)k * 2 * DFF + f0 + 4);
            const f32x4 g0 = *(const f32x4*)(cw + (size_t)k * 2 * DFF + DFF + f0), g1 = *(const f32x4*)(cw + (size_t)k * 2 * DFF + DFF + f0 + 4);
            wa[k][0] = a0.x; wa[k][1] = a0.y; wa[k][2] = a0.z; wa[k][3] = a0.w; wa[k][4] = a1.x; wa[k][5] = a1.y; wa[k][6] = a1.z; wa[k][7] = a1.w;
            wg[k][0] = g0.x; wg[k][1] = g0.y; wg[k][2] = g0.z; wg[k][3] = g0.w; wg[k][4] = g1.x; wg[k][5] = g1.y; wg[k][6] = g1.z; wg[k][7] = g1.w;
        }
        { const f32x4 a0 = *(const f32x4*)(cb + f0), a1 = *(const f32x4*)(cb + f0 + 4), g0 = *(const f32x4*)(cb + DFF + f0), g1 = *(const f32x4*)(cb + DFF + f0 + 4);
          ba[0] = a0.x; ba[1] = a0.y; ba[2] = a0.z; ba[3] = a0.w; ba[4] = a1.x; ba[5] = a1.y; ba[6] = a1.z; ba[7] = a1.w;
          bg[0] = g0.x; bg[1] = g0.y; bg[2] = g0.z; bg[3] = g0.w; bg[4] = g1.x; bg[5] = g1.y; bg[6] = g1.z; bg[7] = g1.w; }
        u32x4 a2 = (u32x4){0u, 0u, 0u, 0u}, g2 = a2, a1 = a2, g1 = a2;
        if ((t0 & 4095) >= 2) { a2 = *(const u32x4*)(U + (size_t)(t0 - 2) * (2 * DFF) + f0); g2 = *(const u32x4*)(U + (size_t)(t0 - 2) * (2 * DFF) + DFF + f0); }
        if ((t0 & 4095) >= 1) { a1 = *(const u32x4*)(U + (size_t)(t0 - 1) * (2 * DFF) + f0); g1 = *(const u32x4*)(U + (size_t)(t0 - 1) * (2 * DFF) + DFF + f0); }
#define CONV_TOKEN(t_, a0_, g0_) do { \
            if (((t_) & 4095) == 0) { a2 = (u32x4){0u, 0u, 0u, 0u}; g2 = a2; a1 = a2; g1 = a2; }       \
            float o[8]; \
            CONV_E(0, LX, a0_, g0_) CONV_E(1, HX, a0_, g0_) CONV_E(2, LY, a0_, g0_) CONV_E(3, HY, a0_, g0_) CONV_E(4, LZ, a0_, g0_) CONV_E(5, HZ, a0_, g0_) CONV_E(6, LW, a0_, g0_) CONV_E(7, HW, a0_, g0_) \
            u32x4 w; w.x = cvtpk(o[0], o[1]); w.y = cvtpk(o[2], o[3]); w.z = cvtpk(o[4], o[5]); w.w = cvtpk(o[6], o[7]); \
            *(u32x4*)(ACT + (size_t)(t_) * DFF + f0) = w; \
            a2 = a1; g2 = g1; a1 = a0_; g1 = g0_; } while (0)
#define CONV_E(j_, W_, a0_, g0_) { const float av = ba[j_] + wa[0][j_] * W_(a2) + wa[1][j_] * W_(a1) + wa[2][j_] * W_(a0_); \
                                   const float gv = bg[j_] + wg[0][j_] * W_(g2) + wg[1][j_] * W_(g1) + wg[2][j_] * W_(g0_); o[j_] = av * sigmoidf_(av) * gv; }
#define LX(v) bflo((v).x)
#define HX(v) bfhi((v).x)
#define LY(v) bflo((v).y)
#define HY(v) bfhi((v).y)
#define LZ(v) bflo((v).z)
#define HZ(v) bfhi((v).z)
#define LW(v) bflo((v).w)
#define HW(v) bfhi((v).w)
        int t = t0;
        for (; t + 5 <= t1; t += 5) {
            u32x4 xa[5], xg[5];
#pragma unroll
            for (int k = 0; k < 5; ++k) { xa[k] = *(const u32x4*)(U + (size_t)(t + k) * (2 * DFF) + f0); xg[k] = *(const u32x4*)(U + (size_t)(t + k) * (2 * DFF) + DFF + f0); }
            CONV_TOKEN(t, xa[0], xg[0]); CONV_TOKEN(t + 1, xa[1], xg[1]); CONV_TOKEN(t + 2, xa[2], xg[2]); CONV_TOKEN(t + 3, xa[3], xg[3]); CONV_TOKEN(t + 4, xa[4], xg[4]);
        }
        for (; t < t1; ++t) {
            const u32x4 xa0 = *(const u32x4*)(U + (size_t)t * (2 * DFF) + f0), xg0 = *(const u32x4*)(U + (size_t)t * (2 * DFF) + DFF + f0);
            CONV_TOKEN(t, xa0, xg0);
        }
#undef CONV_TOKEN
#undef CONV_E
#undef LX
#undef HX
#undef LY
#undef HY
#undef LZ
#undef HZ
#undef LW
#undef HW
    }
}

namespace att {
constexpr int VRS = 144;
constexpr float NEGM = -1e30f, MFLOOR = -1e20f;
#define MFMA32(a, b, c) __builtin_amdgcn_mfma_f32_32x32x16_bf16((a), (b), (c), 0, 0, 0)
DI int crow(int i, int h) { return (i & 3) + 8 * (i >> 2) + 4 * h; }
template <int W1, int W2, int DV>
DI void dma_tile(LAS unsigned char* stage, const bf16_t* K1, int ldk1, const bf16_t* K2, int ldk2, const bf16_t* VT, int ldvt, int k0, int tid, int wave) {
    constexpr int DQK = W1 + W2, CPR = DQK / 8, KSZ = 64 * DQK * 2, KEYM = (DQK == 128) ? 15 : 7;
    const char* k1b = (const char*)(K1 + (size_t)k0 * ldk1); const char* k2b = (W2 != 0) ? (const char*)(K2 + (size_t)k0 * ldk2) : k1b; const char* vb = (const char*)(VT + k0);
#pragma unroll
    for (int i = 0; i < DQK / 64; ++i) { const int id = tid + 512 * i, pos = id / CPR, slot = id % CPR, row = pos ^ ((pos >> 3) & 1), ch = slot ^ (row & KEYM);
        const bool seg1 = (W2 == 0 || ch * 8 < W1);
        const unsigned off = seg1 ? (unsigned)(row * ldk1 + ch * 8) * 2u : (unsigned)(row * ldk2 + (ch * 8 - W1)) * 2u;
        __builtin_amdgcn_global_load_lds((const unsigned*)((seg1 ? k1b : k2b) + off), (LAS unsigned*)(stage + (wave * 64 + 512 * i) * 16), 16, 0, 0); }
#pragma unroll
    for (int i = 0; i < DV / 64; ++i) { const int id = tid + 512 * i, pos = id >> 3, slot = id & 7, d = pos ^ ((pos >> 3) & 1), ch = slot ^ (d & 7);
        const unsigned off = (unsigned)(d * ldvt + ch * 8) * 2u;
        __builtin_amdgcn_global_load_lds((const unsigned*)(vb + off), (LAS unsigned*)(stage + KSZ + (wave * 64 + 512 * i) * 16), 16, 0, 0); }
}
template <int DQK>
DI void qk_tile(f32x16& s0, f32x16& s1, const LAS unsigned char* Kb, const bf16x8 (&qf)[DQK / 16], int r, int h) {
    constexpr int ND = DQK / 16;
    const int rp = r ^ ((r >> 3) & 1), r7 = r & 7, rb = (r >> 3) & 1;
    const LAS unsigned char* kp = Kb + rp * (DQK * 2);
    const LAS unsigned char* kb4[4]; const LAS unsigned char* kb4x[4];
#pragma unroll
    for (int i = 0; i < 4; ++i) { kb4[i] = kp + (((2 * i + h) ^ r7) << 4) + ((DQK == 128) ? rb * 128 : 0); kb4x[i] = kp + (((2 * i + h) ^ r7) << 4) + ((DQK == 128) ? (1 - rb) * 128 : 128); }
    bf16x8 f[3][2];
#define QK_ADDR(d_) ((DQK == 128) ? ((((d_) >> 2) & 1) ? kb4x[(d_) & 3] : kb4[(d_) & 3]) : (kb4[(d_) & 3] + ((d_) >> 2) * 128))
#define QK_LOAD(d_, buf_) do { f[buf_][0] = *(const LAS bf16x8*)(QK_ADDR(d_)); f[buf_][1] = *(const LAS bf16x8*)(QK_ADDR(d_) + 32 * DQK * 2); } while (0)
    QK_LOAD(0, 0); QK_LOAD(1, 1);
#pragma unroll
    for (int d0 = 0; d0 < ND; ++d0) {
        if (d0 + 2 < ND) QK_LOAD(d0 + 2, (d0 + 2) % 3);
        __builtin_amdgcn_sched_barrier(0);
        s0 = MFMA32(f[d0 % 3][0], qf[d0], s0); s1 = MFMA32(f[d0 % 3][1], qf[d0], s1);
    }
#undef QK_LOAD
#undef QK_ADDR
}
constexpr float THR = 8.f;
DI float hmax32(float v) { auto rr = __builtin_amdgcn_permlane32_swap(__float_as_uint(v), __float_as_uint(v), false, false); return fmaxf(__uint_as_float(rr[0]), __uint_as_float(rr[1])); }
DI bool softmax_step(f32x16& x0, f32x16& x1, float toff, float& m, float& l, float& alpha) {
    float mx = __builtin_fmaxf(x0[0], x1[0]);
#pragma unroll
    for (int i = 1; i < 16; ++i) mx = __builtin_fmaxf(__builtin_fmaxf(mx, x0[i]), x1[i]);
    const float mt = hmax32(mx) + toff;
    const bool need = mt > m + THR;
    const float mn = need ? mt : m;
    alpha = __builtin_amdgcn_exp2f(m - mn); m = mn;
    const float sub = mn - toff;
    f32x2_t s2 = {0.f, 0.f};
#pragma unroll
    for (int i = 0; i < 16; ++i) { x0[i] = __builtin_amdgcn_exp2f(x0[i] - sub); x1[i] = __builtin_amdgcn_exp2f(x1[i] - sub); }
#pragma unroll
    for (int i = 0; i < 16; i += 2) { s2 += (f32x2_t){x0[i], x0[i + 1]}; s2 += (f32x2_t){x1[i], x1[i + 1]}; }
    const float s = s2.x + s2.y;
    const bool any = __any(need) != 0;
    l = (any ? l * alpha : l) + s;
    return any;
}
DI bf16x8 pack8(const f32x16& x, int s) {
    u32x4 w; w.x = cvtpk(x[8 * s], x[8 * s + 1]); w.y = cvtpk(x[8 * s + 2], x[8 * s + 3]); w.z = cvtpk(x[8 * s + 4], x[8 * s + 5]); w.w = cvtpk(x[8 * s + 6], x[8 * s + 7]);
    return __builtin_bit_cast(bf16x8, w);
}
DI void pack_p(bf16x8 (&pk)[4], const f32x16& p0, const f32x16& p1) { pk[0] = pack8(p0, 0); pk[1] = pack8(p0, 1); pk[2] = pack8(p1, 0); pk[3] = pack8(p1, 1); }
template <int DV>
DI void pv_tile(f32x16 (&o)[DV / 32], const LAS unsigned char* Vb, const bf16x8 (&pk)[4], int r, int h) {
    constexpr int NS = DV / 16;
    const int r7 = r & 7;
    const LAS unsigned char* vp = Vb + (r ^ ((r >> 3) & 1)) * 128 + h * 8;
    const LAS unsigned char* vb8[8];
#pragma unroll
    for (int i = 0; i < 8; ++i) vb8[i] = vp + ((i ^ r7) << 4);
    s16x4 lo[3][2], hi[3][2];
#define PV_LOAD(s_, buf_) do { _Pragma("unroll") for (int jj = 0; jj < 2; ++jj) { const int j_ = 2 * ((s_) & 1) + jj; \
        lo[buf_][jj] = *(const LAS s16x4*)(vb8[2 * j_] + ((s_) >> 1) * 4096); hi[buf_][jj] = *(const LAS s16x4*)(vb8[2 * j_ + 1] + ((s_) >> 1) * 4096); } } while (0)
    PV_LOAD(0, 0); PV_LOAD(1, 1);
#pragma unroll
    for (int s = 0; s < NS; ++s) {
        if (s + 2 < NS) PV_LOAD(s + 2, (s + 2) % 3);
        __builtin_amdgcn_sched_barrier(0);
#pragma unroll
        for (int jj = 0; jj < 2; ++jj) {
            const bf16x8 vf = __builtin_shufflevector(lo[s % 3][jj], hi[s % 3][jj], 0, 1, 2, 3, 4, 5, 6, 7);
            o[s >> 1] = MFMA32(vf, pk[2 * (s & 1) + jj], o[s >> 1]);
        }
    }
#undef PV_LOAD
}
template <int NQ>
DI void load_q(bf16x8 (&qf)[NQ], const bf16_t* qrow, int h) {
#pragma unroll
    for (int d0 = 0; d0 < NQ; ++d0) qf[d0] = *(const bf16x8*)(qrow + d0 * 16 + h * 8);
}
}

#define ATT_WAITV(n_) asm volatile("s_waitcnt vmcnt(%0)" :: "n"(n_) : "memory")
#define ATT_LOOP_BEGIN(nt_, K0_, W1_, W2_, DV_, K1p_, ldk1_, K2p_, ldk2_, VTp_, ldvt_, XF_, CUMP_, NST_, DIST_) \
  { constexpr int KSZ_ = 64 * ((W1_) + (W2_)) * 2, SSZ_ = KSZ_ + (DV_) * 128, NL_ = ((W1_) + (W2_)) / 64 + (DV_) / 64 + ((XF_) ? 1 : 0), NSTG_ = (NST_); const int nt__ = (nt_); \
    _Pragma("unroll") for (int pt_ = 0; pt_ < (DIST_); ++pt_) { if (pt_ < nt__) { const int t = pt_; att::dma_tile<W1_, W2_, DV_>(Ks + pt_ * SSZ_, K1p_, ldk1_, K2p_, ldk2_, VTp_, ldvt_, (K0_), tid, wave); \
      if (XF_) { if (lane < 16) __builtin_amdgcn_global_load_lds((const unsigned*)((CUMP_) + (K0_) + lane * 4), (LAS unsigned*)(Cw + pt_ * 2048), 16, 0, 0); } } } \
    int sp_ = NSTG_ - 1, sc_ = 0, sn_ = (DIST_); \
    for (int t_ = 0; t_ < nt__; ++t_) { \
      if ((DIST_) == 2 && t_ + 1 < nt__) ATT_WAITV(NL_); else ATT_WAITV(0); \
      __builtin_amdgcn_s_barrier(); asm volatile("" ::: "memory"); \
      if (t_ + (DIST_) < nt__) { const int t = t_ + (DIST_); att::dma_tile<W1_, W2_, DV_>(Ks + sn_ * SSZ_, K1p_, ldk1_, K2p_, ldk2_, VTp_, ldvt_, (K0_), tid, wave); \
        if (XF_) { if (lane < 16) __builtin_amdgcn_global_load_lds((const unsigned*)((CUMP_) + (K0_) + lane * 4), (LAS unsigned*)(Cw + sn_ * 2048), 16, 0, 0); } } \
      { const int t = t_; const int k0 = (K0_); const bool lastt = (t_ + 1 == nt__); const LAS unsigned char* Kb = Ks + sc_ * SSZ_; const LAS unsigned char* Vb = Kb + KSZ_; const LAS unsigned char* Vprev = Ks + sp_ * SSZ_ + KSZ_; \
        const LAS float* Cb = (const LAS float*)(Cw + sc_ * 2048); (void)k0; (void)Kb; (void)Vb; (void)Cb; (void)Vprev; (void)lastt;
#define ATT_LOOP_END() \
      } \
      sp_ = sc_; sc_ = (sc_ == NSTG_ - 1) ? 0 : sc_ + 1; sn_ = (sn_ == NSTG_ - 1) ? 0 : sn_ + 1; } \
    asm volatile("s_waitcnt lgkmcnt(0)" ::: "memory"); __builtin_amdgcn_s_barrier(); asm volatile("" ::: "memory"); }

template <int TYPE>
DI void abc_unit(const Params& p, int l, int bloc, int hd, int qb, LAS unsigned char* lds, int tid, bool dummy) {
    asm volatile("" : "+v"(tid));
    constexpr int W1 = (TYPE == 0) ? 64 : 128, W2 = (TYPE == 1) ? 64 : 0, DQK = W1 + W2, DV = 128, NQ = DQK / 16;
    constexpr int RING = 3 * (64 * DQK * 2 + DV * 128);
    LAS unsigned char* Ks = lds;
    const int lane = tid & 63, wave = __builtin_amdgcn_readfirstlane(tid >> 6), r = lane & 31, h = lane >> 5;
    const int q0 = qb * 256, qw0 = q0 + 32 * wave, qpos = qw0 + r, tb = bloc * SEQ;
    bf16_t* PRM = (bf16_t*)(p.ws + WS_PRM);
    const bf16_t* VTall = (const bf16_t*)(p.ws + WS_VT);
    const float* ctlf = (const float*)(p.ws + WS_CTL);
    const int NT = 4 * (qb + 1);
    const float sl2 = __builtin_amdgcn_exp2f(-2.f * (float)(hd + 1)) * LOG2E;
    float cq2 = 0.f; const float* cum = nullptr;
    if (TYPE == 2) { cum = (const float*)(p.ws + WS_CUM) + (size_t)(bloc * 4 + hd) * SEQ; cq2 = -cum[qpos]; }
    const float sl2h = sl2 * (float)(4 * h);
    LAS unsigned char* Cw = lds + RING + wave * 256;
    LAS unsigned* park = (LAS unsigned*)(lds + RING) + wave * 2048 + lane;
    f32x16 o[4];
    float m, lsum;
    bf16x8 pk[4];
    const bool lagw = wave >= 4;
#pragma nounroll
    for (int pass = 0; pass < ((TYPE == 0) ? 2 : 1); ++pass) {
        const bf16_t *Qp, *K1p, *K2p = nullptr, *VTp; int ldq, ldk1, ldk2 = 0;
        if (TYPE == 0) { Qp = PRM + C_AQ + hd * 128 + pass * 64; ldq = LDP; K1p = PRM + (size_t)tb * LDP + C_AK + hd * 128 + pass * 64; ldk1 = LDP; VTp = VTall + (size_t)(R_AV + hd * 128) * LDVT + tb; }
        else if (TYPE == 1) { Qp = (const bf16_t*)(p.ws + WS_QF) + hd * 192; ldq = 768; K1p = (const bf16_t*)(p.ws + WS_KN) + (size_t)tb * 512 + hd * 128; ldk1 = 512;
                              K2p = PRM + (size_t)tb * LDP + C_KR; ldk2 = LDP; VTp = (const bf16_t*)(p.ws + WS_MVT) + (size_t)(hd * 128) * LDVT + tb; }
        else { Qp = PRM + C_CQ + hd * 128; ldq = LDP; K1p = PRM + (size_t)tb * LDP + C_CK + hd * 128; ldk1 = LDP; VTp = VTall + (size_t)(R_CV + hd * 128) * LDVT + tb; }
        bf16x8 qf[NQ];
        att::load_q<NQ>(qf, Qp + (size_t)(tb + qpos) * ldq, h);
        m = att::MFLOOR; lsum = 0.f;
#pragma unroll
        for (int db = 0; db < 4; ++db)
#pragma unroll
            for (int i = 0; i < 16; ++i) o[db][i] = 0.f;
        bool havep = false;
        ATT_LOOP_BEGIN(NT, (NT - 1 - t) * 64, W1, W2, DV, K1p, ldk1, K2p, ldk2, VTp, LDVT, (TYPE == 2), cum, 3, 1)
            if (lagw && havep) att::pv_tile<DV>(o, Vprev, pk, r, h);
            if (k0 <= qw0 + 31) {
                f32x16 s0, s1; float toff;
                if (TYPE == 0) {
#pragma unroll
                    for (int i = 0; i < 16; ++i) { s0[i] = __builtin_fmaf(sl2, (float)((i & 3) + 8 * (i >> 2)), sl2h); s1[i] = s0[i] + sl2 * 32.f; }
                    toff = sl2 * (float)(k0 - qpos);
                } else if (TYPE == 2) {
#pragma unroll
                    for (int k = 0; k < 4; ++k) { const f32x4 c0 = *(const LAS f32x4*)(Cb + 8 * k + 4 * h), c1 = *(const LAS f32x4*)(Cb + 32 + 8 * k + 4 * h);
                        s0[4 * k] = c0.x; s0[4 * k + 1] = c0.y; s0[4 * k + 2] = c0.z; s0[4 * k + 3] = c0.w; s1[4 * k] = c1.x; s1[4 * k + 1] = c1.y; s1[4 * k + 2] = c1.z; s1[4 * k + 3] = c1.w; }
                    toff = cq2;
                } else {
#pragma unroll
                    for (int i = 0; i < 16; ++i) { s0[i] = 0.f; s1[i] = 0.f; }
                    toff = 0.f;
                }
                att::qk_tile<DQK>(s0, s1, Kb, qf, r, h);
                if (k0 + 63 > qw0) {
                    asm volatile("" ::: "memory");
#pragma unroll
                    for (int i = 0; i < 16; ++i) { const int kv = k0 + att::crow(i, h); if (kv > qpos) s0[i] = att::NEGM; if (kv + 32 > qpos) s1[i] = att::NEGM; }
                }
                float alpha;
                if (att::softmax_step(s0, s1, toff, m, lsum, alpha)) {
#pragma unroll
                    for (int db = 0; db < 4; ++db)
#pragma unroll
                        for (int i = 0; i < 16; ++i) o[db][i] *= alpha;
                }
                att::pack_p(pk, s0, s1);
                if (!lagw || lastt) att::pv_tile<DV>(o, Vb, pk, r, h); else havep = true;
            }
        ATT_LOOP_END()
        const float lt = hsum32(lsum);
        const float inv = lt > 0.f ? 1.f / lt : 0.f;
        if (TYPE == 0 && pass == 0) {
#pragma unroll
            for (int db = 0; db < 4; ++db)
#pragma unroll
                for (int i = 0; i < 8; ++i) park[(db * 8 + i) * 64] = cvtpk(o[db][2 * i] * inv, o[db][2 * i + 1] * inv);
        } else {
#pragma unroll
            for (int db = 0; db < 4; ++db)
#pragma unroll
                for (int i = 0; i < 16; ++i) o[db][i] *= inv;
        }
    }
    int qp2 = qpos; asm volatile("" : "+v"(qp2)); qp2 += tb;
    bf16_t* Yp = PRM + (size_t)qp2 * LDP + ((TYPE == 0) ? C_AQ : (TYPE == 1) ? C_YB : C_CQ) + hd * 128;
    if (dummy) Yp = (bf16_t*)(p.ws + WS_MRG) + (size_t)qp2 * 1024 + hd * 128;
    if (TYPE == 0) {
        const float lam = ctlf[CF_LAM], lam_init = ctlf[CF_LAM + 1];
        const float* sub = p.in[4] + (size_t)l * 128;
        float ss = 0.f;
#pragma unroll
        for (int db = 0; db < 4; ++db)
#pragma unroll
            for (int i = 0; i < 8; ++i) { const unsigned pw = park[(db * 8 + i) * 64]; const float a = bflo(pw) - lam * o[db][2 * i], b = bfhi(pw) - lam * o[db][2 * i + 1]; o[db][2 * i] = a; o[db][2 * i + 1] = b; ss += a * a + b * b; }
        ss = hsum32(ss);
        const float rs = (1.f - lam_init) / sqrtf(ss * (1.f / 128.f) + EPS);
#pragma unroll
        for (int db = 0; db < 4; ++db)
#pragma unroll
            for (int k = 0; k < 4; ++k) { const int d = 32 * db + 8 * k + 4 * h; const f32x4 gg = *(const f32x4*)(sub + d);
                o[db][4 * k] *= rs * gg.x; o[db][4 * k + 1] *= rs * gg.y; o[db][4 * k + 2] *= rs * gg.z; o[db][4 * k + 3] *= rs * gg.w; }
    }
#pragma unroll
    for (int db = 0; db < 4; ++db)
#pragma unroll
        for (int k = 0; k < 4; ++k) { u32x2 w; w.x = cvtpk(o[db][4 * k], o[db][4 * k + 1]); w.y = cvtpk(o[db][4 * k + 2], o[db][4 * k + 3]); *(u32x2*)(Yp + 32 * db + 8 * k + 4 * h) = w; }
}

DI void nsa_unit(const Params& p, int l, int bloc, int g, int qblk, LAS unsigned char* lds, int tid, bool dummy) {
    asm volatile("" : "+v"(tid));
    LAS unsigned char* Ks = lds; LAS unsigned char* Cw = lds;
    LAS float* IMP = (LAS float*)(lds + 65536);
    LAS unsigned* SELM = (LAS unsigned*)(lds + 65536 + 66560);
    LAS int* SELT = (LAS int*)(lds + 65536 + 66560 + 512);
    const int lane = tid & 63, wave = __builtin_amdgcn_readfirstlane(tid >> 6), r = lane & 31, h = lane >> 5;
    const int hg = wave >> 1, qrow = 32 * (wave & 1) + r, q0 = qblk * 64, qpos = q0 + qrow, blk = qblk, hh = g * 4 + hg, tb = bloc * SEQ;
    bf16_t* PRM = (bf16_t*)(p.ws + WS_PRM);
    const bf16_t* VTall = (const bf16_t*)(p.ws + WS_VT);
    const float sl2 = __builtin_amdgcn_exp2f(-(float)(hh + 1)) * LOG2E;
    bf16_t* qrowp = PRM + (size_t)(tb + qpos) * LDP;
    bf16x8 qf[4]; att::load_q<4>(qf, qrowp + C_DQ + hh * 64, h);
    const float gt0 = bf2f(qrowp[C_DG + hh * 3]), gt1 = bf2f(qrowp[C_DG + hh * 3 + 1]), gt2 = bf2f(qrowp[C_DG + hh * 3 + 2]);
    for (int i = tid; i < 4 * 64 * 65; i += 512) IMP[i] = 0.f;
    f32x16 tot[2], o[2];
    float m, ls;
    bf16x8 pk[4];
    const bool lagw = wave >= 4;
    const bf16_t* KCp = (const bf16_t*)(p.ws + WS_KC) + (size_t)(bloc * 2 + g) * 256 * 64;
    const bf16_t* VCp = (const bf16_t*)(p.ws + WS_VCT) + (size_t)(bloc * 2 + g) * 64 * 256;
    const int ntc = ((q0 + 32) >> 10) + 1;
    const float sl2h = sl2 * (float)(4 * h);
#define PAT(i) __builtin_fmaf(sl2, (float)(((i) & 3) + 8 * ((i) >> 2)), sl2h)
#define CMP_SCORES() \
        f32x16 s0, s1; \
        _Pragma("unroll") for (int i = 0; i < 16; ++i) { s0[i] = 16.f * PAT(i); s1[i] = s0[i] + sl2 * 512.f; } \
        const float toff = sl2 * (float)(16 * k0 + 31 - qpos); \
        att::qk_tile<64>(s0, s1, Kb, qf, r, h); \
        _Pragma("unroll") for (int i = 0; i < 16; ++i) { const int d0 = qpos - 31 - 16 * (k0 + att::crow(i, h)); if (d0 < 0) s0[i] = att::NEGM; if (d0 < 512) s1[i] = att::NEGM; }
    m = att::MFLOOR; ls = 0.f;
    ATT_LOOP_BEGIN(ntc, (ntc - 1 - t) * 64, 64, 0, 64, KCp, 64, (const bf16_t*)nullptr, 0, VCp, 256, false, (const float*)nullptr, 4, 2)
        CMP_SCORES();
        float alpha; (void)att::softmax_step(s0, s1, toff, m, ls, alpha);
    ATT_LOOP_END()
    {
        const float lt = hsum32(ls); const float inv = lt > 0.f ? 1.f / lt : 0.f;
#pragma unroll
        for (int db = 0; db < 2; ++db)
#pragma unroll
            for (int i = 0; i < 16; ++i) o[db][i] = 0.f;
        LAS float* improw = IMP + (hg * 64 + qrow) * 65;
        ATT_LOOP_BEGIN(ntc, (ntc - 1 - t) * 64, 64, 0, 64, KCp, 64, (const bf16_t*)nullptr, 0, VCp, 256, false, (const float*)nullptr, 4, 2)
            CMP_SCORES();
            const float sub = m - toff;
#pragma unroll
            for (int i = 0; i < 16; ++i) { s0[i] = __builtin_amdgcn_exp2f(s0[i] - sub) * inv; s1[i] = __builtin_amdgcn_exp2f(s1[i] - sub) * inv; }
#pragma unroll
            for (int k = 0; k < 4; ++k) {
                const int j = (k0 >> 2) + 2 * k + h;
                const float sp0 = 0.5f * s0[4 * k + 3], sp1 = 0.5f * s1[4 * k + 3];
                __hip_atomic_fetch_add(improw + j, (s0[4 * k] + s0[4 * k + 1]) + (s0[4 * k + 2] + sp0), __ATOMIC_RELAXED, __HIP_MEMORY_SCOPE_WORKGROUP);
                __hip_atomic_fetch_add(improw + j + 1, sp0, __ATOMIC_RELAXED, __HIP_MEMORY_SCOPE_WORKGROUP);
                __hip_atomic_fetch_add(improw + j + 8, (s1[4 * k] + s1[4 * k + 1]) + (s1[4 * k + 2] + sp1), __ATOMIC_RELAXED, __HIP_MEMORY_SCOPE_WORKGROUP);
                __hip_atomic_fetch_add(improw + j + 9, sp1, __ATOMIC_RELAXED, __HIP_MEMORY_SCOPE_WORKGROUP);
            }
            att::pack_p(pk, s0, s1); att::pv_tile<64>(o, Vb, pk, r, h);
        ATT_LOOP_END()
#pragma unroll
        for (int db = 0; db < 2; ++db)
#pragma unroll
            for (int i = 0; i < 16; ++i) tot[db][i] = gt0 * o[db][i];
    }
    for (int rr = 0; rr < 8; ++rr) {
        const int q = wave * 8 + rr, j = lane;
        float v = ((IMP[(0 * 64 + q) * 65 + j] + IMP[(1 * 64 + q) * 65 + j]) + IMP[(2 * 64 + q) * 65 + j]) + IMP[(3 * 64 + q) * 65 + j];
        const bool forced = (j == 0) | (j == blk) | (j == blk - 1);
        v = (j > blk) ? -3.0e38f : (forced ? 1.0e9f : v);
        int cnt = 0;
#pragma unroll 4
        for (int i = 0; i < 64; ++i) { const float vi = __uint_as_float((unsigned)__builtin_amdgcn_readlane((int)__float_as_uint(v), i)); cnt += ((vi > v) || (vi == v && i < j)) ? 1 : 0; }
        const unsigned long long mask = __ballot((cnt < 8) && (j <= blk));
        if (lane == 0) { SELM[2 * q] = (unsigned)mask; SELM[2 * q + 1] = (unsigned)(mask >> 32); }
    }
    __syncthreads();
    unsigned ulo = SELM[2 * lane], uhi = SELM[2 * lane + 1];
    ulo = wave_or(ulo); uhi = wave_or(uhi);
    const int nts = __builtin_amdgcn_readfirstlane(__popc(ulo) + __popc(uhi));
    if (tid < 64) { const unsigned long long un = ((unsigned long long)uhi << 32) | ulo;
        if ((un >> tid) & 1ull) SELT[__popcll(un & ((1ull << tid) - 1ull))] = tid; }
    const unsigned mylo = SELM[2 * qrow], myhi = SELM[2 * qrow + 1];
    __syncthreads();
    LAS float* tpark = IMP + wave * 2048 + lane;
#pragma unroll
    for (int db = 0; db < 2; ++db)
#pragma unroll
        for (int i = 0; i < 16; ++i) tpark[(db * 16 + i) * 64] = tot[db][i];
    {
        const bf16_t* K1p = PRM + (size_t)tb * LDP + C_DKS + g * 64; const bf16_t* VTp = VTall + (size_t)(R_DVS + g * 64) * LDVT + tb;
        m = att::MFLOOR; ls = 0.f;
#pragma unroll
        for (int db = 0; db < 2; ++db)
#pragma unroll
            for (int i = 0; i < 16; ++i) o[db][i] = 0.f;
        bool havep = false;
        ATT_LOOP_BEGIN(nts, SELT[nts - 1 - t] * 64, 64, 0, 64, K1p, LDP, (const bf16_t*)nullptr, 0, VTp, LDVT, false, (const float*)nullptr, 4, 2)
            if (lagw && havep) { att::pv_tile<64>(o, Vprev, pk, r, h); havep = false; }
            const int j = k0 >> 6; const bool lsel = ((j < 32 ? (mylo >> j) : (myhi >> (j - 32))) & 1u) != 0u;
            if (__any(lsel)) {
                f32x16 s0, s1;
#pragma unroll
                for (int i = 0; i < 16; ++i) { s0[i] = PAT(i); s1[i] = s0[i] + sl2 * 32.f; }
                const float toff = lsel ? sl2 * (float)(k0 - qpos) : att::NEGM;
                att::qk_tile<64>(s0, s1, Kb, qf, r, h);
                if (j == blk) {
                    asm volatile("" ::: "memory");
#pragma unroll
                    for (int i = 0; i < 16; ++i) { const int kv = k0 + att::crow(i, h); if (kv > qpos) s0[i] = att::NEGM; if (kv + 32 > qpos) s1[i] = att::NEGM; }
                }
                float alpha;
                if (att::softmax_step(s0, s1, toff, m, ls, alpha)) {
#pragma unroll
                    for (int db = 0; db < 2; ++db)
#pragma unroll
                        for (int i = 0; i < 16; ++i) o[db][i] *= alpha;
                }
                att::pack_p(pk, s0, s1);
                if (!lagw || lastt) att::pv_tile<64>(o, Vb, pk, r, h); else havep = true;
            }
        ATT_LOOP_END()
        const float lt = hsum32(ls); const float inv = (lt > 0.f ? 1.f / lt : 0.f) * gt1;
#pragma unroll
        for (int db = 0; db < 2; ++db)
#pragma unroll
            for (int i = 0; i < 16; ++i) tpark[(db * 16 + i) * 64] += inv * o[db][i];
    }
    {
        const bf16_t* K1p = PRM + (size_t)tb * LDP + C_DKW + g * 64; const bf16_t* VTp = VTall + (size_t)(R_DVW + g * 64) * LDVT + tb;
        const int t0 = blk > 4 ? blk - 4 : 0, ntw = blk - t0 + 1;
        m = att::MFLOOR; ls = 0.f;
#pragma unroll
        for (int db = 0; db < 2; ++db)
#pragma unroll
            for (int i = 0; i < 16; ++i) o[db][i] = 0.f;
        bool havep = false;
        ATT_LOOP_BEGIN(ntw, (blk - t) * 64, 64, 0, 64, K1p, LDP, (const bf16_t*)nullptr, 0, VTp, LDVT, false, (const float*)nullptr, 4, 2)
            if (lagw && havep) att::pv_tile<64>(o, Vprev, pk, r, h);
            f32x16 s0, s1;
#pragma unroll
            for (int i = 0; i < 16; ++i) { s0[i] = PAT(i); s1[i] = s0[i] + sl2 * 32.f; }
            const float toff = sl2 * (float)(k0 - qpos);
            att::qk_tile<64>(s0, s1, Kb, qf, r, h);
            if (t == 0 || t + 1 == ntw) {
                asm volatile("" ::: "memory");
#pragma unroll
                for (int i = 0; i < 16; ++i) { const int d0 = qpos - (k0 + att::crow(i, h)), d1 = d0 - 32;
                    if (d0 < 0 || d0 >= 256) s0[i] = att::NEGM; if (d1 < 0 || d1 >= 256) s1[i] = att::NEGM; }
            }
            float alpha;
            if (att::softmax_step(s0, s1, toff, m, ls, alpha)) {
#pragma unroll
                for (int db = 0; db < 2; ++db)
#pragma unroll
                    for (int i = 0; i < 16; ++i) o[db][i] *= alpha;
            }
            att::pack_p(pk, s0, s1);
            if (!lagw || lastt) att::pv_tile<64>(o, Vb, pk, r, h); else havep = true;
        ATT_LOOP_END()
        const float lt = hsum32(ls); const float inv = (lt > 0.f ? 1.f / lt : 0.f) * gt2;
#pragma unroll
        for (int db = 0; db < 2; ++db)
#pragma unroll
            for (int i = 0; i < 16; ++i) tot[db][i] = tpark[(db * 16 + i) * 64] + inv * o[db][i];
    }
    int qp2 = qpos; asm volatile("" : "+v"(qp2)); qp2 += tb;
    bf16_t* Yp = PRM + (size_t)qp2 * LDP + C_DQ + hh * 64;
    if (dummy) Yp = (bf16_t*)(p.ws + WS_MRG) + (size_t)qp2 * 1024 + hh * 64;
#pragma unroll
    for (int db = 0; db < 2; ++db)
#pragma unroll
        for (int k = 0; k < 4; ++k) { u32x2 w; w.x = cvtpk(tot[db][4 * k], tot[db][4 * k + 1]); w.y = cvtpk(tot[db][4 * k + 2], tot[db][4 * k + 3]); *(u32x2*)(Yp + 32 * db + 8 * k + 4 * h) = w; }
#undef CMP_SCORES
#undef PAT
}

#define XB_TMO      128
#define XB_XCNT(j)  (256  + 64 * (j))
#define XB_XSUB(j)  (1280 + 64 * (j))
#define XB_XGEN(j)  (2304 + 64 * (j))
#define XB_TOP      3328
#define XB_TOPGEN   3392
#define XCD_BAR_WORDS 3456
#define XB_SPIN_CAP (1u << 20)
DI unsigned xb_ld(unsigned* p)              { return __hip_atomic_load(p, __ATOMIC_RELAXED, __HIP_MEMORY_SCOPE_AGENT); }
DI unsigned xb_add(unsigned* p, unsigned v) { return __hip_atomic_fetch_add(p, v, __ATOMIC_RELAXED, __HIP_MEMORY_SCOPE_AGENT); }
DI unsigned xb_xcc_id() { return (unsigned)__builtin_amdgcn_s_getreg((3 << 11) | 20) & 0xFu; }
#define XB_SPIN(cond, bar) do { unsigned _sp = 0; while (cond) { __builtin_amdgcn_s_sleep(1); \
    if ((++_sp & 255u) == 0u) { if (xb_ld(&(bar)[XB_TMO])) break; if (_sp > XB_SPIN_CAP) { atomicAdd(&(bar)[XB_TMO], 1u); break; } } } } while (0)
struct XcdBarrier { unsigned* bar; unsigned x; volatile LAS unsigned* st; };
DI XcdBarrier xcd_barrier_post(unsigned* bar, volatile LAS unsigned* st) {
    XcdBarrier b; b.bar = bar; b.x = xb_xcc_id(); b.st = st;
    if (threadIdx.x == 0) (void)xb_add(&bar[XB_XCNT(b.x)], 1u);
    return b;
}
DI void xcd_barrier_complete(unsigned* bar, unsigned x, unsigned& nloc, unsigned& nx) {
    const unsigned G = gridDim.x * gridDim.y * gridDim.z;
    unsigned sum, cnt, mine, sp = 0u;
    for (;;) {
        sum = 0u; cnt = 0u; mine = 0u;
#pragma unroll
        for (unsigned j = 0; j < 16; ++j) { const unsigned c = xb_ld(&bar[XB_XCNT(j)]); sum += c; cnt += (c > 0u) ? 1u : 0u; mine = (j == x) ? c : mine; }
        if (sum == G) break;
        __builtin_amdgcn_s_sleep(1);
        if ((++sp & 255u) == 0u) { if (xb_ld(&bar[XB_TMO])) break; if (sp > XB_SPIN_CAP) { atomicAdd(&bar[XB_TMO], 1u); break; } }
    }
    nloc = mine > 0u ? mine : 1u; nx = cnt > 0u ? cnt : 1u;
}
DI void xcd_barrier(const XcdBarrier& b, int tid) {
    asm volatile("s_waitcnt vmcnt(0)" ::: "memory");
    __syncthreads();
    if (tid == 0) {
        unsigned* bar = b.bar;
        __builtin_amdgcn_s_waitcnt(0);
        unsigned nloc = b.st[0], nx = b.st[1];
        if (nloc == 0u) { xcd_barrier_complete(bar, b.x, nloc, nx); b.st[0] = nloc; b.st[1] = nx; }
        const unsigned old = xb_add(&bar[XB_XSUB(b.x)], 1u);
        const unsigned gen = old / nloc;
        if (old + 1u == (gen + 1u) * nloc) {
            __builtin_amdgcn_fence(__ATOMIC_RELEASE, "agent");
            asm volatile("s_waitcnt vmcnt(0)" ::: "memory");
            const unsigned og = xb_add(&bar[XB_TOP], 1u);
            const unsigned tg = og / nx;
            if (og + 1u == (tg + 1u) * nx) xb_add(&bar[XB_TOPGEN], 1u);
            else XB_SPIN(xb_ld(&bar[XB_TOPGEN]) == tg, bar);
            __builtin_amdgcn_fence(__ATOMIC_ACQUIRE, "agent");
            xb_add(&bar[XB_XGEN(b.x)], 1u);
            asm volatile("s_waitcnt vmcnt(0)" ::: "memory");
        } else {
            XB_SPIN(xb_ld(&bar[XB_XGEN(b.x)]) == gen, bar);
            __builtin_amdgcn_fence(__ATOMIC_ACQUIRE, "agent");
            asm volatile("s_waitcnt vmcnt(0)" ::: "memory");
        }
    }
    __syncthreads();
}

constexpr int N_UNITS = 1280, CW_ORDER = 8192;
DI float unit_cost(int u) {
    if (u < 768) { const int qb = u / 48, type = (u % 48) >> 4; return (float)(qb + 1) * (type == 0 ? 10.7f : 8.7f); }
    const int i2 = u - 768, qblk = i2 >> 3, g = i2 & 1; return 1000.f + (float)qblk + 0.5f * (float)g;
}
constexpr int LDS_BYTES = 147456, LDS_MISC = LDS_BYTES - 512;
__global__ void __launch_bounds__(512, 2) mega_fwd(Params p) {
    extern __shared__ __attribute__((aligned(16))) unsigned char smem[];
    LAS unsigned char* lds = (LAS unsigned char*)smem;
    cg::grid_group grid = cg::this_grid();
    const int G = gridDim.x, bid = blockIdx.x, ngw = G * 8, gthreads = G * 512;
    const int wave0 = __builtin_amdgcn_readfirstlane((int)(threadIdx.x >> 6));
    { volatile LAS unsigned* bst0 = (volatile LAS unsigned*)(lds + LDS_MISC + 64); if (threadIdx.x == 0) { bst0[0] = 0u; bst0[1] = 0u; } }
    __syncthreads();
    volatile LAS unsigned* bst = (volatile LAS unsigned*)(lds + LDS_MISC + 64);
    (void)xcd_barrier_post((unsigned*)(p.ws + WS_CTL) + CW_BAR, bst);
    for (int l = 0; l < 2; ++l) {
        for (int c = 0; c < NCHUNK; ++c) {
#ifndef PROBE_S
#define PROBE_S -1
#endif
            for (int s_ = 0; s_ < ((PROBE_S >= 0) ? 20 : 19); ++s_) {
                const int s = (s_ == 19) ? PROBE_S : (s_ < 4) ? s_ : (s_ == 4) ? 18 : (s_ < 8) ? s_ - 1 : (s_ == 8) ? 17 : s_ - 2;
                unsigned char* ws = p.ws; asm volatile("" : "+s"(ws));
                unsigned* ctl = (unsigned*)(ws + WS_CTL); float* ctlf = (float*)ctl;
                bf16_t* H = (bf16_t*)(ws + WS_H); bf16_t* PRM = (bf16_t*)(ws + WS_PRM); bf16_t* GATES = (bf16_t*)(ws + WS_GATES);
                bf16_t* WIN = (bf16_t*)(ws + WS_WIN); bf16_t* WUKV = (bf16_t*)(ws + WS_WUKV); bf16_t* MRG = (bf16_t*)(ws + WS_MRG);
                const size_t tok0 = (size_t)c * TC;
                const float* xin = (l == 0) ? p.in[0] : p.out;
                bool isg = false;
                pg8::Gemm g{nullptr, nullptr, 0, 0, 0, 0, 0};
                pg8::Epi E{pg8::M_PLAIN, 0, nullptr, 0, nullptr, nullptr, nullptr, nullptr};
                switch (s) {
                case 1: g = pg8::Gemm{H, WIN, TC, C_GATE, DM, DM, DM}; E.mode = pg8::M_INRM; E.o0 = PRM; E.o1 = GATES; E.o2 = (bf16_t*)(ws + WS_CKV); E.f0 = (float*)(ws + WS_LOGF); E.f1 = p.in[9] + l * 4; isg = true; break;
                case 2: g = pg8::Gemm{WIN + (size_t)N_RM * DM, H, N_TR, TC, DM, DM, DM}; E.o0 = (bf16_t*)(ws + WS_VT); E.ld0 = LDVT; isg = true; break;
                case 3: g = pg8::Gemm{(bf16_t*)(ws + WS_CKV), (bf16_t*)(ws + WS_WC1), 4096, 256, 2048, 1024, 2048}; E.mode = pg8::M_CMP1; E.o0 = (bf16_t*)(ws + WS_HID); E.f1 = ctlf + CF_PEB; isg = true; break;
                case 4: g = pg8::Gemm{PRM + C_BCQ, (bf16_t*)(ws + WS_WUQ), TC, 768, 256, LDP, 256}; E.mode = pg8::M_QF; E.o0 = (bf16_t*)(ws + WS_QF); isg = true; break;
                case 5: g = pg8::Gemm{PRM + C_BCKV, WUKV, TC, 512, 256, LDP, 256}; E.o0 = (bf16_t*)(ws + WS_KN); E.ld0 = 512; isg = true; break;
                case 6: g = pg8::Gemm{WUKV + 512 * 256, PRM + C_BCKV, 512, TC, 256, 256, LDP}; E.o0 = (bf16_t*)(ws + WS_MVT); E.ld0 = LDVT; isg = true; break;
                case 8: case 9: case 10: case 11: { const int n = s - 8; const int yc = (n == 0) ? C_AQ : (n == 1) ? C_YB : (n == 2) ? C_CQ : C_DQ;
                    g = pg8::Gemm{PRM + yc, (bf16_t*)(ws + WS_WBR) + (size_t)n * 1024 * 512, TC, DM, 512, LDP, 512}; E.mode = pg8::M_MERGE; E.aux = n; E.o0 = MRG; E.o1 = GATES; isg = true; } break;
                case 12: g = pg8::Gemm{MRG, (bf16_t*)(ws + WS_WOUT), TC, DM, DM, DM, DM}; E.mode = pg8::M_OUT; E.f0 = p.out + tok0 * DM; E.f1 = xin + tok0 * DM; isg = true; break;
                case 14: g = pg8::Gemm{H, (bf16_t*)(ws + WS_WUP), TC, 2 * DFF, DM, DM, DM}; E.o0 = (bf16_t*)(ws + WS_U); E.ld0 = 2 * DFF; isg = true; break;
                case 16: g = pg8::Gemm{(bf16_t*)(ws + WS_ACT), (bf16_t*)(ws + WS_WDN), TC, DM, DFF, DFF, DFF}; E.mode = pg8::M_DOWN; E.f0 = p.out + tok0 * DM; isg = true; break;
                case 18: g = pg8::Gemm{(bf16_t*)(ws + WS_H8), (bf16_t*)(ws + WS_WG8), TC, 4096, DM / 2, DM / 2, DM / 2}; E.mode = pg8::M_GATE8; E.o1 = GATES; isg = true; break;
                case 17: g = pg8::Gemm{(bf16_t*)(ws + WS_HID), (bf16_t*)(ws + WS_WC2), 4096, 256, 128, 128, 128}; E.mode = pg8::M_CMP2; E.o0 = (bf16_t*)(ws + WS_KC); E.o1 = (bf16_t*)(ws + WS_VCT); isg = true; break;
                default: break;
                }
#ifndef NO_G
#ifndef PROBE_STEP
#define PROBE_STEP -1
#endif
                if (isg) { const int rot = (s == 2 || s == 5 || s == 17) ? 64 : (s == 6) ? 192 : 0;
                    pg8::StaticOrder S; S.init(g.M, g.N, G, (bid + rot) % G);
                    if (s == 18) { if (bid >= 16) { S.init(g.M, g.N, G - 16, bid - 16); pg8::gemm_phase<true>(lds, g, S, E, fresh_tid(wave0)); } }
                    else pg8::gemm_phase<false>(lds, g, S, E, fresh_tid(wave0)); }
#endif
#define STEP_TID() const int tid = fresh_tid(wave0), lane = tid & 63, wave = wave0, gw = bid * 8 + wave, gtid = bid * 512 + tid; (void)lane; (void)gw; (void)gtid; (void)wave
                switch (s) {
                case 0: { STEP_TID();
                    if (l == 0 && c == 0 && bid < 3) {
                        LAS float* cst = (LAS float*)lds;
                        for (int u = tid; u < N_UNITS; u += 512) cst[u] = unit_cost(u);
                        if (gtid < 128) { unsigned zz; asm volatile("v_mov_b32 %0, 0" : "=v"(zz)); ((u32x4*)(ws + WS_CKV + (size_t)8 * MiB))[gtid] = (u32x4){zz, zz, zz, zz}; }
                        __syncthreads();
                        if (gtid < N_UNITS) { const float mine = cst[gtid]; int rank = 0;
                            for (int u = 0; u < N_UNITS; ++u) { const float cu = cst[u]; rank += (cu > mine || (cu == mine && u < gtid)) ? 1 : 0; }
                            ((int*)ctl)[CW_ORDER + rank] = gtid; }
                        __syncthreads();
                    }
                    if (c == 0) prologue_weights(p, l, lds, gw, ngw, wave, lane);
                    { const float* gmix = p.in[1] + l * DM;
                      for (int mrow = 2 * gw; mrow < TC; mrow += 2 * ngw) norm_row_bf16_x2(xin + (tok0 + mrow) * DM, xin + (tok0 + mrow + 1) * DM, gmix, H + (size_t)mrow * DM, H + (size_t)(mrow + 1) * DM, lane, ws + WS_H8 + (size_t)mrow * DM, ws + WS_H8 + (size_t)(mrow + 1) * DM); }
                    } break;
                case 3: { STEP_TID();
                    { const float* gq = p.in[5] + l * 256; const float* gkv = p.in[7] + l * 256;
                      for (int it = 4 * gw; it < 2 * TC; it += 4 * ngw) {
                        bf16_t* const rr[4] = {PRM + (size_t)(it >> 1) * LDP + C_BCQ, PRM + (size_t)(it >> 1) * LDP + C_BCQ + 256, PRM + (size_t)((it >> 1) + 1) * LDP + C_BCQ, PRM + (size_t)((it >> 1) + 1) * LDP + C_BCQ + 256};
                        const float* const gg[4] = {gq, gkv, gq, gkv};
                        norm256_inplace_x4(rr, gg, lane); } }
                    if (bid >= G - 16) cumsum_block((const float*)(ws + WS_LOGF), (float*)(ws + WS_CUM), bid - (G - 16), tid, (LAS float*)(lds + 131072));
                    } break;
                case 7: {
#ifndef ATT_REPS
#define ATT_REPS 1
#endif
                    for (int rep = 0; rep < ATT_REPS; ++rep) {
                    const bool dummy = rep + 1 < ATT_REPS;
                    unsigned* ctr = ctl + CW_ATT + 64 * (l * 2 + c) + rep;
                    LAS int* sidx = (LAS int*)(lds + LDS_MISC);
                    for (;;) {
                        const int tid = fresh_tid(wave0);
                        if (tid == 0) *sidx = (int)atomicAdd(ctr, 1u);
                        __syncthreads();
                        const int idx = __builtin_amdgcn_readfirstlane(*sidx);
                        __syncthreads();
                        if (idx >= N_UNITS) break;
                        const int un = __builtin_amdgcn_readfirstlane(((const int*)ctl)[CW_ORDER + idx]);
                        if (un < 768) {
                            const int qb = un / 48, rem = un % 48, type = rem >> 4, bh = rem & 15, bloc = bh >> 2, hd = bh & 3;
#ifndef NO_A
                            if (type == 0) abc_unit<0>(p, l, bloc, hd, qb, lds, tid, dummy);
#endif
#ifndef NO_B
                            if (type == 1) abc_unit<1>(p, l, bloc, hd, qb, lds, tid, dummy);
#endif
#ifndef NO_C
                            if (type == 2) abc_unit<2>(p, l, bloc, hd, qb, lds, tid, dummy);
#endif
                        } else {
                            const int i2 = un - 768, qblk = i2 >> 3, rem = i2 & 7;
#ifndef NO_D
                            nsa_unit(p, l, rem >> 1, rem & 1, qblk, lds, tid, dummy);
#endif
                        }
                    }
                    }
                } break;
                case 13: { STEP_TID();
                    { const float* gffn = p.in[15] + l * DM;
                      for (int mrow = 2 * gw; mrow < TC; mrow += 2 * ngw) norm_row_bf16_x2(p.out + (tok0 + mrow) * DM, p.out + (tok0 + mrow + 1) * DM, gffn, H + (size_t)mrow * DM, H + (size_t)(mrow + 1) * DM, lane); }
                    } break;
                case 15: { STEP_TID(); conv_phase(p, l, gtid, gthreads); } break;
                default: break;
                }
                const bool sync_after = (s_ == 19) || !(s == 1 || s == 3 || s == 4 || s == 5 || s == 6 || s == 8 || s == 9 || s == 10);
                if (sync_after) { if (l == 0 && c == 0 && s_ == 0) grid.sync(); else { XcdBarrier xb; xb.bar = ctl + CW_BAR; xb.x = xb_xcc_id(); xb.st = (volatile LAS unsigned*)(lds + LDS_MISC + 64); xcd_barrier(xb, fresh_tid(wave0)); } }
            }
        }
    }
    { const int lane = (int)__builtin_amdgcn_mbcnt_hi(~0u, __builtin_amdgcn_mbcnt_lo(~0u, 0u)), gw = bid * 8 + wave0;
      const float* gfin = p.in[20];
      for (int mrow = 2 * gw; mrow < TALL; mrow += 2 * ngw) {
        float* x0 = p.out + (size_t)mrow * DM; float* x1 = x0 + DM;
        f32x4 v[2][4]; float s[2] = {0.f, 0.f};
#pragma unroll
        for (int k = 0; k < 2; ++k)
#pragma unroll
            for (int j = 0; j < 4; ++j) v[k][j] = ((const f32x4*)(k ? x1 : x0))[64 * j + lane];
#pragma unroll
        for (int k = 0; k < 2; ++k)
#pragma unroll
            for (int j = 0; j < 4; ++j) s[k] += (v[k][j].x * v[k][j].x + v[k][j].y * v[k][j].y) + (v[k][j].z * v[k][j].z + v[k][j].w * v[k][j].w);
#pragma unroll
        for (int k = 0; k < 2; ++k) { const float rs = 1.f / sqrtf(wave_sum(s[k]) * (1.f / DM) + EPS);
#pragma unroll
            for (int j = 0; j < 4; ++j) { const f32x4 gg = ((const f32x4*)gfin)[64 * j + lane];
                ((f32x4*)(k ? x1 : x0))[64 * j + lane] = (f32x4){v[k][j].x * rs * gg.x, v[k][j].y * rs * gg.y, v[k][j].z * rs * gg.z, v[k][j].w * rs * gg.w}; } }
      } }
}

extern "C" void kernel_launch(void* const* d_in, const int* in_sizes, int n_in, void* d_out, int out_size, void* d_ws, size_t ws_size, hipStream_t stream) {
    static int grid = 0;
    if (grid == 0) {
        if (n_in != 21 || out_size != TALL * DM || ws_size < WS_END) { fprintf(stderr, "kernel_launch: unexpected shapes (n_in %d out %d ws %zu)\n", n_in, out_size, ws_size); grid = -1; return; }
        int dev = 0, cus = 0, per_cu = 0;
        (void)hipGetDevice(&dev);
        (void)hipDeviceGetAttribute(&cus, hipDeviceAttributeMultiprocessorCount, dev);
        if (hipFuncSetAttribute((const void*)mega_fwd, hipFuncAttributeMaxDynamicSharedMemorySize, LDS_BYTES) != hipSuccess) { fprintf(stderr, "kernel_launch: hipFuncSetAttribute failed\n"); }
        if (hipOccupancyMaxActiveBlocksPerMultiprocessor(&per_cu, (const void*)mega_fwd, 512, LDS_BYTES) != hipSuccess || per_cu < 1) { fprintf(stderr, "kernel_launch: occupancy query gave %d\n", per_cu); per_cu = 1; }
        (void)hipGetLastError();
        grid = cus * 1;
    }
    if (grid < 0) return;
    (void)hipMemsetAsync(d_ws, 0, 32768, stream);
    Params p{};
    for (int i = 0; i < 21; ++i) p.in[i] = (const float*)d_in[i];
    p.out = (float*)d_out; p.ws = (unsigned char*)d_ws;
    void* args[] = {&p};
    hipError_t e = hipLaunchCooperativeKernel((const void*)mega_fwd, dim3(grid), dim3(512), args, LDS_BYTES, stream);
    if (e != hipSuccess) fprintf(stderr, "cooperative launch failed: %s (grid %d)\n", hipGetErrorString(e), grid);
}
```
